# Optimizing an MI355X kernel written in HIP

```python
import math
import jax, jax.numpy as jnp
from jax import lax
import numpy as np


D_MODEL = 2048
BATCH = 4
SEQ = 4096
DEPTH = 1

MEM_LEN = 256
ATT_HEADS = 8
ATT_HEAD_DIM = 128
ATT_WIDTH = ATT_HEADS * ATT_HEAD_DIM
MOBA_BLOCK = 256
MOBA_TOPK = 3
MOBA_Q_CHUNK = 32
REL_BUCKETS = 32
REL_MAX_DIST = 128
GDN_HEADS = 8
GDN_HEAD_DIM = 128
GDN_WIDTH = GDN_HEADS * GDN_HEAD_DIM
GDN_CONV = 4
GDN_CHUNK = 64
XATT_HEADS = 4
XATT_HEAD_DIM = 128
XATT_WIDTH = XATT_HEADS * XATT_HEAD_DIM
D_FF = 5632
NORM_EPS = 1e-6
IN_SPLITS = (3 * ATT_WIDTH, 3 * GDN_WIDTH, GDN_WIDTH, GDN_HEADS, GDN_HEADS, D_MODEL, D_MODEL)
IN_WIDTH = sum(IN_SPLITS)

kernel_name = 'hybrid_moba_gdn_macaron_block'


def rms_norm(x, gain):
    xf = x.astype(jnp.float32)
    y = xf * lax.rsqrt(jnp.mean(xf * xf, axis=-1, keepdims=True) + NORM_EPS)
    return (y * gain.astype(jnp.float32)).astype(x.dtype)


def swiglu(x, w_gate, w_up, w_down):
    return (jax.nn.silu(x @ w_gate) * (x @ w_up)) @ w_down


def t5_bucket(rel):
    n = jnp.maximum(rel, 0)
    max_exact = REL_BUCKETS // 2
    nf = jnp.maximum(n, 1).astype(jnp.float32)
    large = max_exact + (jnp.log(nf / max_exact) / math.log(REL_MAX_DIST / max_exact)
                         * (REL_BUCKETS - max_exact)).astype(jnp.int32)
    large = jnp.minimum(large, REL_BUCKETS - 1)
    return jnp.where(n < max_exact, n, large)


def moba_attention(q, k, v, rel_bias):
    B, S, H, D = q.shape
    nb = -(-S // MOBA_BLOCK)
    s_pad = nb * MOBA_BLOCK
    k_sel_n = min(MOBA_TOPK, nb)
    n_sel = k_sel_n * MOBA_BLOCK
    q = (q * D ** -0.5).transpose(0, 2, 1, 3)
    pad = ((0, 0), (0, 0), (0, s_pad - S), (0, 0))
    kb = jnp.pad(k.transpose(0, 2, 1, 3), pad).reshape(B, H, nb, MOBA_BLOCK, D)
    vb = jnp.pad(v.transpose(0, 2, 1, 3), pad).reshape(B, H, nb, MOBA_BLOCK, D)
    k_mean = jnp.mean(kb, axis=3, dtype=jnp.float32)
    bias_t = rel_bias.astype(jnp.float32).T
    bi = jnp.arange(B)[:, None, None, None]
    hi = jnp.arange(H)[None, :, None, None]
    offs = jnp.arange(MOBA_BLOCK)

    def chunk(c):
        start = c * MOBA_Q_CHUNK
        q_c = lax.dynamic_slice_in_dim(q, start, MOBA_Q_CHUNK, axis=2)
        pos = start + jnp.arange(MOBA_Q_CHUNK)
        own = start // MOBA_BLOCK
        score = jnp.einsum('bhqd,bhnd->bhqn', q_c.astype(jnp.float32), k_mean)
        score = jnp.where(jnp.arange(nb) < own, score, -jnp.inf)
        _, sel = lax.top_k(score, k_sel_n)
        sel_ok = sel < own
        k_g = kb[bi, hi, sel]
        v_g = vb[bi, hi, sel]
        k_o = lax.dynamic_index_in_dim(kb, own, axis=2, keepdims=False)
        v_o = lax.dynamic_index_in_dim(vb, own, axis=2, keepdims=False)
        s_sel = jnp.einsum('bhqd,bhqnkd->bhqnk', q_c, k_g).astype(jnp.float32)
        s_own = jnp.einsum('bhqd,bhkd->bhqk', q_c, k_o).astype(jnp.float32)
        kpos_sel = sel[..., None] * MOBA_BLOCK + offs
        kpos_own = own * MOBA_BLOCK + offs
        b_sel = bias_t[hi[..., None], t5_bucket(pos[:, None, None] - kpos_sel)]
        b_own = bias_t[jnp.arange(H)[:, None, None], t5_bucket(pos[:, None] - kpos_own)[None]]
        s_sel = jnp.where(sel_ok[..., None], s_sel + b_sel, -jnp.inf)
        s_own = jnp.where(kpos_own <= pos[:, None], s_own + b_own, -jnp.inf)
        logits = jnp.concatenate([s_sel.reshape(B, H, MOBA_Q_CHUNK, n_sel), s_own], axis=-1)
        p = jax.nn.softmax(logits, axis=-1).astype(v.dtype)
        p_sel = p[..., :n_sel].reshape(B, H, MOBA_Q_CHUNK, k_sel_n, MOBA_BLOCK)
        return (jnp.einsum('bhqnk,bhqnkd->bhqd', p_sel, v_g)
                + jnp.einsum('bhqk,bhkd->bhqd', p[..., n_sel:], v_o))

    out = lax.map(chunk, jnp.arange(S // MOBA_Q_CHUNK))
    return out.transpose(1, 0, 3, 2, 4).reshape(B, S, H * D)


def chunk_gated_delta_rule(q, k, v, g, beta):
    B, S, H, Dk = q.shape
    Dv = v.shape[-1]
    C = GDN_CHUNK
    N = S // C
    to_chunks = lambda t: t.reshape(B, N, C, H, -1).transpose(0, 3, 1, 2, 4)
    q, k, v = to_chunks(q), to_chunks(k), to_chunks(v)
    g = g.reshape(B, N, C, H).transpose(0, 3, 1, 2)
    beta = beta.reshape(B, N, C, H).transpose(0, 3, 1, 2)
    G = jnp.cumsum(g, axis=-1)
    idx = jnp.arange(C)
    incl = idx[:, None] >= idx[None, :]
    strict = idx[:, None] > idx[None, :]
    decay = jnp.exp(jnp.where(incl, G[..., :, None] - G[..., None, :], -jnp.inf))
    kb = k * beta[..., None]
    m = jnp.where(strict, jnp.einsum('bhncd,bhnjd->bhncj', kb, k) * decay, 0.0)
    rhs = jnp.concatenate([v * beta[..., None], kb * jnp.exp(G)[..., None]], axis=-1)
    sol = lax.linalg.triangular_solve(m + jnp.eye(C, dtype=m.dtype), rhs,
                                      left_side=True, lower=True, unit_diagonal=True)
    u, w = sol[..., :Dv], sol[..., Dv:]
    attn = jnp.einsum('bhncd,bhnjd->bhncj', q, k) * decay
    q_dec = q * jnp.exp(G)[..., None]
    k_dec = k * jnp.exp(G[..., -1:] - G)[..., None]
    chunk_decay = jnp.exp(G[..., -1])
    xs = tuple(jnp.moveaxis(t, 2, 0) for t in (u, w, attn, q_dec, k_dec, chunk_decay))

    def step(state, inp):
        u_n, w_n, a_n, qd_n, kd_n, cd_n = inp
        v_new = u_n - jnp.einsum('bhck,bhkv->bhcv', w_n, state)
        o_n = (jnp.einsum('bhck,bhkv->bhcv', qd_n, state)
               + jnp.einsum('bhcj,bhjv->bhcv', a_n, v_new))
        state = state * cd_n[..., None, None] + jnp.einsum('bhck,bhcv->bhkv', kd_n, v_new)
        return state, o_n

    state0 = jnp.zeros((B, H, Dk, Dv), jnp.float32)
    _, o = lax.scan(step, state0, xs)
    return o.transpose(1, 0, 3, 2, 4).reshape(B, S, H, Dv)


def l2_normalize(t):
    return t * lax.rsqrt(jnp.sum(t * t, axis=-1, keepdims=True) + NORM_EPS)


def gated_deltanet(qkv_raw, z, b_logit, a_logit, conv_w, a_log, dt_bias, out_norm):
    dtype = qkv_raw.dtype
    B, S, Cn = qkv_raw.shape
    qkv = lax.conv_general_dilated(qkv_raw, conv_w[:, None, :].astype(dtype), (1,),
                                   [(GDN_CONV - 1, 0)], dimension_numbers=('NWC', 'WIO', 'NWC'),
                                   feature_group_count=Cn)
    qkv = jax.nn.silu(qkv).astype(jnp.float32).reshape(B, S, 3, GDN_HEADS, GDN_HEAD_DIM)
    q = l2_normalize(qkv[:, :, 0]) * GDN_HEAD_DIM ** -0.5
    k = l2_normalize(qkv[:, :, 1])
    v = qkv[:, :, 2]
    beta = jax.nn.sigmoid(b_logit.astype(jnp.float32))
    g = -jnp.exp(a_log.astype(jnp.float32)) * jax.nn.softplus(
        a_logit.astype(jnp.float32) + dt_bias.astype(jnp.float32))
    o = chunk_gated_delta_rule(q, k, v, g, beta)
    o = o * lax.rsqrt(jnp.mean(o * o, axis=-1, keepdims=True) + NORM_EPS)
    o = o * out_norm.astype(jnp.float32) * jax.nn.silu(
        z.astype(jnp.float32).reshape(B, S, GDN_HEADS, GDN_HEAD_DIM))
    return o.reshape(B, S, GDN_WIDTH).astype(dtype)


def memory_cross_attention(h_n, mem_n, wq, wkv, wo):
    B, S, _ = h_n.shape
    M = mem_n.shape[1]
    q = (h_n @ wq).reshape(B, S, XATT_HEADS, XATT_HEAD_DIM)
    kv = (mem_n @ wkv).reshape(B, M, 2, XATT_HEADS, XATT_HEAD_DIM)
    s = jnp.einsum('bshd,bmhd->bhsm', q, kv[:, :, 0]).astype(jnp.float32) * XATT_HEAD_DIM ** -0.5
    p = jax.nn.softmax(s, axis=-1).astype(kv.dtype)
    o = jnp.einsum('bhsm,bmhd->bshd', p, kv[:, :, 1]).reshape(B, S, XATT_WIDTH)
    return o @ wo


def setup_inputs(seed: int = 0) -> dict:
    key = jax.random.key(seed)
    ks = jax.random.split(key, 28)
    f32 = jnp.float32

    def dense(k, fan_in, fan_out):
        return jax.random.normal(k, (DEPTH, fan_in, fan_out), f32) * fan_in ** -0.5

    def gain(k, n):
        return 1.0 + 0.01 * jax.random.normal(k, (DEPTH, n), f32)

    dt = jnp.exp(jax.random.uniform(ks[10], (DEPTH, GDN_HEADS), f32,
                                    minval=math.log(1e-3), maxval=math.log(1e-1)))
    return {
        'x': jax.random.normal(ks[0], (BATCH, SEQ, D_MODEL), f32),
        'mem': jax.random.normal(ks[1], (BATCH, MEM_LEN, D_MODEL), f32),
        'ffn1_norm': gain(ks[2], D_MODEL),
        'ffn1_w_gate': dense(ks[3], D_MODEL, D_FF),
        'ffn1_w_up': dense(ks[4], D_MODEL, D_FF),
        'ffn1_w_down': dense(ks[5], D_FF, D_MODEL),
        'mix_norm': gain(ks[6], D_MODEL),
        'w_in': dense(ks[7], D_MODEL, IN_WIDTH),
        'gdn_conv': jax.random.normal(ks[8], (DEPTH, GDN_CONV, 3 * GDN_WIDTH), f32) * GDN_CONV ** -0.5,
        'gdn_a_log': jnp.log(jax.random.uniform(ks[9], (DEPTH, GDN_HEADS), f32, minval=1.0, maxval=16.0)),
        'gdn_dt_bias': dt + jnp.log(-jnp.expm1(-dt)),
        'gdn_out_norm': gain(ks[11], GDN_HEAD_DIM),
        'rel_bias': 0.5 * jax.random.normal(ks[12], (REL_BUCKETS, ATT_HEADS), f32),
        'w_branch_attn': dense(ks[13], ATT_WIDTH, D_MODEL),
        'w_branch_delta': dense(ks[14], GDN_WIDTH, D_MODEL),
        'w_out': dense(ks[15], D_MODEL, D_MODEL),
        'cross_norm': gain(ks[16], D_MODEL),
        'mem_norm': gain(ks[17], D_MODEL),
        'cross_wq': dense(ks[18], D_MODEL, XATT_WIDTH),
        'cross_wkv': dense(ks[19], D_MODEL, 2 * XATT_WIDTH),
        'cross_wo': dense(ks[20], XATT_WIDTH, D_MODEL),
        'ffn2_norm': gain(ks[21], D_MODEL),
        'ffn2_w_gate': dense(ks[22], D_MODEL, D_FF),
        'ffn2_w_up': dense(ks[23], D_MODEL, D_FF),
        'ffn2_w_down': dense(ks[24], D_FF, D_MODEL),
        'final_norm': 1.0 + 0.01 * jax.random.normal(ks[25], (D_MODEL,), f32),
    }


def reference(x, mem, ffn1_norm, ffn1_w_gate, ffn1_w_up, ffn1_w_down, mix_norm, w_in,
              gdn_conv, gdn_a_log, gdn_dt_bias, gdn_out_norm, rel_bias, w_branch_attn,
              w_branch_delta, w_out, cross_norm, mem_norm, cross_wq, cross_wkv, cross_wo,
              ffn2_norm, ffn2_w_gate, ffn2_w_up, ffn2_w_down, final_norm):
    B, S, _ = x.shape
    split_at = np.cumsum(IN_SPLITS)[:-1].tolist()
    h = x
    for l in range(DEPTH):
        h = h + 0.5 * swiglu(rms_norm(h, ffn1_norm[l]), ffn1_w_gate[l], ffn1_w_up[l], ffn1_w_down[l])
        u = rms_norm(h, mix_norm[l])
        att_qkv, gdn_qkv, gdn_z, gdn_b, gdn_a, gate_a, gate_b = jnp.split(u @ w_in[l], split_at, axis=-1)
        att_qkv = att_qkv.reshape(B, S, 3, ATT_HEADS, ATT_HEAD_DIM)
        y_att = moba_attention(att_qkv[:, :, 0], att_qkv[:, :, 1], att_qkv[:, :, 2], rel_bias) @ w_branch_attn[l]
        y_del = gated_deltanet(gdn_qkv, gdn_z, gdn_b, gdn_a, gdn_conv[l], gdn_a_log[l],
                               gdn_dt_bias[l], gdn_out_norm[l]) @ w_branch_delta[l]
        merged = jax.nn.sigmoid(gate_a) * y_att + jax.nn.sigmoid(gate_b) * y_del
        h = h + merged @ w_out[l]
        h = h + memory_cross_attention(rms_norm(h, cross_norm[l]), rms_norm(mem, mem_norm[l]),
                                       cross_wq[l], cross_wkv[l], cross_wo[l])
        h = h + 0.5 * swiglu(rms_norm(h, ffn2_norm[l]), ffn2_w_gate[l], ffn2_w_up[l], ffn2_w_down[l])
    return rms_norm(h, final_norm)
```

```cpp
#include <hip/hip_runtime.h>
#include <hip/hip_cooperative_groups.h>
#include <cstdio>
#include <cstdint>
namespace cg = cooperative_groups;

#ifndef MK_SINGLE
#define MK_SINGLE 1
#endif
#define PROBE_PHASE -1
#define PROBE_FLAGS 0

#define LAS __attribute__((address_space(3)))
typedef unsigned short bf16_t;
typedef short bf16x8 __attribute__((ext_vector_type(8)));
typedef short s16x4 __attribute__((ext_vector_type(4)));
typedef float f32x4 __attribute__((ext_vector_type(4)));
typedef unsigned u32x4 __attribute__((ext_vector_type(4)));
typedef unsigned u32x2 __attribute__((ext_vector_type(2)));
typedef unsigned long long u64;
__device__ __forceinline__ u64 ssq_fix(float v) { return (u64)(v * 4294967296.f); }
__device__ __forceinline__ float ssq_val(u64 v) { return (float)v * (1.f / 4294967296.f); }

typedef __bf16 hbf2 __attribute__((ext_vector_type(2)));
typedef float f32x2 __attribute__((ext_vector_type(2)));
__device__ __forceinline__ unsigned pk2(float lo, float hi) { const f32x2 v = {lo, hi}; return __builtin_bit_cast(unsigned, __builtin_convertvector(v, hbf2)); }
__device__ __forceinline__ unsigned f2bf(float f) { return pk2(f, 0.f) & 0xffffu; }
__device__ __forceinline__ float bf2f(unsigned h) { return __builtin_bit_cast(float, h << 16); }
__device__ __forceinline__ float bflo(unsigned w) { return __builtin_bit_cast(float, w << 16); }
__device__ __forceinline__ float bfhi(unsigned w) { return __builtin_bit_cast(float, w & 0xffff0000u); }
__device__ __forceinline__ float sigmoidf_(float x) { return __builtin_amdgcn_rcpf(1.f + __builtin_amdgcn_exp2f(-1.4426950408889634f * x)); }
__device__ __forceinline__ float wave_sum(float v) {
#pragma unroll
    for (int o = 1; o < 64; o <<= 1) v += __shfl_xor(v, o);
    return v;
}

__device__ __forceinline__ void lds_barrier() { asm volatile("s_waitcnt lgkmcnt(0)" ::: "memory"); __builtin_amdgcn_s_barrier(); asm volatile("" ::: "memory"); }
__device__ __forceinline__ LAS unsigned char* vbase(LAS unsigned char* p) { unsigned v = (unsigned)(uintptr_t)p; asm volatile("" : "+v"(v)); return (LAS unsigned char*)(uintptr_t)v; }
constexpr int TOK = 16384, DM = 2048, FF = 5632, NGU = 11264, NIN = 11520, SEQ = 4096;
constexpr int C_GDN = 3072, C_Z = 6144, C_GA = 7168, C_GB = 9216, C_BA = 11264;
constexpr float EPS = 1e-6f;
constexpr int NTHREADS = 512, NWAVES = 8;
constexpr int LDS_BYTES = 158 * 1024;

constexpr size_t MiB = 1u << 20;
constexpr size_t WS_CTL = 0;
constexpr size_t WS_KMEAN = 1 * MiB;
constexpr size_t WS_CD = 648 * 1024;
constexpr size_t WS_BAR = 768 * 1024;
constexpr size_t WS_WBA = 2 * MiB, WS_WBD = 6 * MiB, WS_WOUT = 10 * MiB, WS_WQ = 18 * MiB, WS_WKV = 20 * MiB, WS_WO = 24 * MiB;
constexpr size_t WS_HALO = 26 * MiB;
constexpr size_t WS_BAF = 30 * MiB + 512 * 1024;
constexpr size_t WS_RSTDO = 31 * MiB + 512 * 1024;
constexpr size_t WS_MEMB = 32 * MiB, WS_KVX = 36 * MiB;
constexpr size_t WS_HB = 38 * MiB;
constexpr size_t WS_WBUF = 102 * MiB;
constexpr size_t WS_WIN = 102 * MiB;
constexpr size_t WS_ATTN = 507 * MiB;
constexpr size_t WS_PROJ = 147 * MiB;
constexpr size_t WS_HFF = 147 * MiB;
constexpr size_t WS_WGU = 323 * MiB, WS_WD = 367 * MiB;
constexpr size_t WS_QX = 389 * MiB, WS_OX = 405 * MiB;
constexpr size_t WS_END = 523 * MiB;
constexpr int CT_SSQ = 0;
constexpr int CT_SSQM = 10 * 16384;
constexpr int CT_CNT = 10 * 16384 + 1024;

namespace pg8 {
constexpr int BM = 256, BK = 64, HALF = 128, HTB = HALF * BK * 2, STAGE_BYTES = 8 * HTB, NXCD = 8, WGM_WIDE = 4, WGM_NARROW = 2;
__host__ __device__ __forceinline__ int lds_byte(int r, int c) { const int st = (r >> 4) * 2 + (c >> 5), rr = r & 15, cc = c & 31, ob = rr * 64 + cc * 2; return st * 1024 + (ob ^ (((ob >> 9) & 1) << 5)); }
__host__ __device__ __forceinline__ void stage_rc(int b, int& R, int& C) { const int st = b / 1024, sb = b % 1024, swz = sb ^ (((sb >> 9) & 1) << 5); R = (st >> 1) * 16 + swz / 64; C = (st & 1) * 32 + (swz % 64) / 2; }
__host__ __device__ __forceinline__ int perm32(int rho) { const int n = rho >> 4, i = rho & 15; return 8 * (i >> 2) + 4 * n + (i & 3); }
struct Unit { int pm, pn; };
struct Gemm { const bf16_t* A; const bf16_t* Bt; int M, N, K, lda; };
struct StaticOrder {
    int nM, nN, nwg, G, c, wgm;
    __device__ void init(int M, int N, int G_, int c_) { nM = M / BM; nN = N / BM; nwg = nM * nN; G = G_; c = c_; wgm = (nN >= 16) ? WGM_WIDE : WGM_NARROW; }
    __device__ bool next(int i, Unit& u) const {
        const long L = (long)i * G + c; if (L >= nwg) return false;
        int wgid = (int)L; { const int q = nwg / NXCD, r = nwg % NXCD, xcd = wgid % NXCD, off = wgid / NXCD; wgid = (xcd < r ? xcd * (q + 1) : r * (q + 1) + (xcd - r) * q) + off; }
        const int nig = wgm * nN, gid = wgid / nig, fm = gid * wgm, gsz = (nM - fm) < wgm ? (nM - fm) : wgm;
        u.pm = fm + ((wgid % nig) % gsz); u.pn = (wgid % nig) / gsz; return true;
    }
};

enum { E_GU = 0, E_RESID = 1, E_SCALE = 2, E_BR1 = 3, E_BR2 = 4 };
struct Epi {
    int mode;
    const u64* ssq; const float* ssqf;
    bf16_t* outb; int ldo;
    const float* hin; float* hout; float alpha; u64* ssq_out; bf16_t* hb; const bf16_t* hinb;
    bf16_t* halo; float* baf;
    const bf16_t* gate;
    __device__ __forceinline__ void operator()(const f32x4 (&acc)[2][2][4][2], const Unit& u, int wr, int wc, int fr, int fq) const {
        const int row0 = u.pm * BM + wr * 64 + fr;
        const int cl = wc * 32 + 8 * fq;
        if (mode == E_GU || mode == E_SCALE) {
            float rs[2][4];
#pragma unroll
            for (int ai = 0; ai < 2; ++ai)
#pragma unroll
                for (int m = 0; m < 4; ++m) rs[ai][m] = ssqf ? ssqf[row0 + ai * HALF + m * 16] : ssq_val(ssq[row0 + ai * HALF + m * 16]);
#pragma unroll
            for (int ai = 0; ai < 2; ++ai)
#pragma unroll
                for (int m = 0; m < 4; ++m) rs[ai][m] = __builtin_amdgcn_rsqf(rs[ai][m] * (1.f / DM) + EPS);
            if (mode == E_GU) {
#pragma unroll
                for (int ai = 0; ai < 2; ++ai)
#pragma unroll
                    for (int m = 0; m < 4; ++m) {
                        const int row = row0 + ai * HALF + m * 16; const float r = rs[ai][m];
                        float o[8];
#pragma unroll
                        for (int n = 0; n < 2; ++n)
#pragma unroll
                            for (int e = 0; e < 4; ++e) { const float g = acc[ai][0][m][n][e] * r, up = acc[ai][1][m][n][e] * r; o[n * 4 + e] = g * sigmoidf_(g) * up; }
                        u32x4 w; w.x = pk2(o[0], o[1]); w.y = pk2(o[2], o[3]); w.z = pk2(o[4], o[5]); w.w = pk2(o[6], o[7]);
                        *(u32x4*)(outb + (size_t)row * ldo + u.pn * 128 + cl) = w;
                    }
            } else {
                const bool is_ba = (baf != nullptr) && (u.pn * BM == C_BA);
                const bool is_gdn = (halo != nullptr) && (u.pn * BM >= C_GDN) && (u.pn * BM < C_Z);
#pragma unroll
                for (int ai = 0; ai < 2; ++ai)
#pragma unroll
                    for (int m = 0; m < 4; ++m) {
                        const int row = row0 + ai * HALF + m * 16; const float r = rs[ai][m];
#pragma unroll
                        for (int bj = 0; bj < 2; ++bj) {
                            const int col = u.pn * BM + bj * HALF + cl;
                            const f32x4 v0 = acc[ai][bj][m][0] * r, v1 = acc[ai][bj][m][1] * r;
                            u32x4 w; w.x = pk2(v0[0], v0[1]); w.y = pk2(v0[2], v0[3]); w.z = pk2(v1[0], v1[1]); w.w = pk2(v1[2], v1[3]);
                            if (is_ba) { if (bj == 0 && cl < 16) { *(f32x4*)(baf + (size_t)row * 16 + cl) = v0; *(f32x4*)(baf + (size_t)row * 16 + cl + 4) = v1; } }
                            else *(u32x4*)(outb + (size_t)row * ldo + col) = w;
                            if (is_gdn && m == 3 && fr >= 13) *(u32x4*)(halo + ((size_t)(row >> 6) * 3 + (fr - 13)) * 3072 + (col - C_GDN)) = w;
                        }
                    }
            }
        } else if (mode == E_RESID) {
#pragma unroll
            for (int ai = 0; ai < 2; ++ai) {
                f32x4 hv[4][2][2];
                {
                    u32x4 hr[4][2];
#pragma unroll
                    for (int m = 0; m < 4; ++m)
#pragma unroll
                        for (int bj = 0; bj < 2; ++bj) hr[m][bj] = *(const u32x4*)(hinb + (size_t)(row0 + ai * HALF + m * 16) * DM + u.pn * BM + bj * HALF + cl);
                    asm volatile("" ::: "memory");
#pragma unroll
                    for (int m = 0; m < 4; ++m)
#pragma unroll
                        for (int bj = 0; bj < 2; ++bj) { const u32x4 r = hr[m][bj]; hv[m][bj][0] = (f32x4){bflo(r.x), bfhi(r.x), bflo(r.y), bfhi(r.y)}; hv[m][bj][1] = (f32x4){bflo(r.z), bfhi(r.z), bflo(r.w), bfhi(r.w)}; }
                }
#pragma unroll
                for (int m = 0; m < 4; ++m) {
                    const int row = row0 + ai * HALF + m * 16; float ss = 0.f;
#pragma unroll
                    for (int bj = 0; bj < 2; ++bj) {
                        const size_t off = (size_t)row * DM + u.pn * BM + bj * HALF + cl;
                        const f32x4 o0 = hv[m][bj][0] + acc[ai][bj][m][0] * alpha, o1 = hv[m][bj][1] + acc[ai][bj][m][1] * alpha;
                        ss += (o0[0] * o0[0] + o0[1] * o0[1]) + (o0[2] * o0[2] + o0[3] * o0[3]) + (o1[0] * o1[0] + o1[1] * o1[1]) + (o1[2] * o1[2] + o1[3] * o1[3]);
                        if (hb) { u32x4 w; w.x = pk2(o0[0], o0[1]); w.y = pk2(o0[2], o0[3]); w.z = pk2(o1[0], o1[1]); w.w = pk2(o1[2], o1[3]); *(u32x4*)(hb + off) = w; }
                    }
                    ss += __shfl_xor(ss, 16); ss += __shfl_xor(ss, 32);
                    if (fq == 0) atomicAdd(ssq_out + row, ssq_fix(ss));
                }
            }
        } else {
#pragma unroll
            for (int ai = 0; ai < 2; ++ai) {
                u32x4 cv[4][2], gv[4][2];
#pragma unroll
                for (int m = 0; m < 4; ++m)
#pragma unroll
                    for (int bj = 0; bj < 2; ++bj) { const size_t off = (size_t)(row0 + ai * HALF + m * 16) * ldo + u.pn * BM + bj * HALF + cl;
                        cv[m][bj] = *(const u32x4*)(outb + off); gv[m][bj] = (mode == E_BR2) ? *(const u32x4*)(gate + off) : (u32x4){0u, 0u, 0u, 0u}; }
                asm volatile("" ::: "memory");
#pragma unroll
                for (int m = 0; m < 4; ++m)
#pragma unroll
                    for (int bj = 0; bj < 2; ++bj) {
                        const size_t off = (size_t)(row0 + ai * HALF + m * 16) * ldo + u.pn * BM + bj * HALF + cl;
                        const u32x4 cur = cv[m][bj], gb = gv[m][bj];
                        float o[8];
                        if (mode == E_BR1) {
#pragma unroll
                            for (int e = 0; e < 4; ++e) { o[2 * e] = sigmoidf_(bflo(cur[e])) * acc[ai][bj][m][e >> 1][(2 * e) & 3]; o[2 * e + 1] = sigmoidf_(bfhi(cur[e])) * acc[ai][bj][m][e >> 1][(2 * e + 1) & 3]; }
                        } else {
#pragma unroll
                            for (int e = 0; e < 4; ++e) { o[2 * e] = bflo(cur[e]) + sigmoidf_(bflo(gb[e])) * acc[ai][bj][m][e >> 1][(2 * e) & 3]; o[2 * e + 1] = bfhi(cur[e]) + sigmoidf_(bfhi(gb[e])) * acc[ai][bj][m][e >> 1][(2 * e + 1) & 3]; }
                        }
                        u32x4 w; w.x = pk2(o[0], o[1]); w.y = pk2(o[2], o[3]); w.z = pk2(o[4], o[5]); w.w = pk2(o[6], o[7]);
                        *(u32x4*)(outb + off) = w;
                    }
            }
        }
    }
};
__device__ __forceinline__ int rfl(int v) { return __builtin_amdgcn_readfirstlane(v); }
template <class T> __device__ __forceinline__ T* rflp(T* p) { const unsigned long long v = (unsigned long long)p; const unsigned lo = (unsigned)rfl((int)(unsigned)v), hi = (unsigned)rfl((int)(unsigned)(v >> 32)); return (T*)(((unsigned long long)hi << 32) | lo); }
__device__ __forceinline__ Epi load_epi(const LAS Epi* p) {
    Epi e; e.ssqf = rflp(p->ssqf); e.mode = rfl(p->mode);
#ifdef FORCE_MODE
    e.mode = FORCE_MODE;
#endif
 e.ssq = rflp(p->ssq); e.outb = rflp(p->outb); e.ldo = rfl(p->ldo); e.hin = rflp(p->hin); e.hout = rflp(p->hout);
    e.alpha = __builtin_bit_cast(float, rfl(__builtin_bit_cast(int, p->alpha))); e.ssq_out = rflp(p->ssq_out); e.hb = rflp(p->hb); e.halo = rflp(p->halo); e.baf = rflp(p->baf); e.gate = rflp(p->gate); e.hinb = rflp(p->hinb);
    return e;
}
__device__ __forceinline__ void gemm_phase(LAS unsigned char* lds, const Gemm g, const StaticOrder& S, const LAS Epi* Ep, const int tid) {
    const int wid = __builtin_amdgcn_readfirstlane(tid >> 6), lane = tid & 63, wr = wid >> 2, wc = wid & 3, fr = lane & 15, fq = lane >> 4;
    const int K = g.K, nt = K / BK, lda = g.lda;
    unsigned voffA[2], voffB[2];
#pragma unroll
    for (int i = 0; i < 2; ++i) { int R, C; stage_rc(tid * 16 + i * 8192, R, C); const int Rb = (R & ~31) + perm32(R & 31);
        voffA[i] = (unsigned)(R * lda + C) * 2u; voffB[i] = (unsigned)(Rb * K + C) * 2u; }
    const size_t kstep = (size_t)(BK * 2);
    const size_t hstepA = (size_t)HALF * lda * 2, hstepB = (size_t)HALF * K * 2;
    const size_t tstepA = 2 * hstepA, tstepB = 2 * hstepB;
    const unsigned ldsw = (unsigned)wid * 1024u;
    const int aoff = lds_byte(wr * 64 + fr, fq * 8), boff = lds_byte(wc * 32 + fr, fq * 8);
#define PG8_SA(b, h) (((b) * 2 + (h)) * HTB)
#define PG8_SB(b, h) ((4 + (b) * 2 + (h)) * HTB)
#define PG8_STAGE(bufoff, gbase, voff) do { _Pragma("unroll") for (int _i = 0; _i < 2; ++_i) \
        __builtin_amdgcn_global_load_lds((const unsigned*)((const char*)(gbase) + (voff)[_i]), (LAS unsigned*)(lds + (bufoff) + ldsw + _i * 8192), 16, 0, 0); } while (0)
#define PG8_LDA(dst, b, h) do { _Pragma("unroll") for (int m = 0; m < 4; ++m) _Pragma("unroll") for (int k = 0; k < 2; ++k) dst[m][k] = *(const LAS bf16x8*)(lds + PG8_SA(b, h) + aoff + m * 2048 + k * 1024); } while (0)
#define PG8_LDB(dst, b, h) do { _Pragma("unroll") for (int n = 0; n < 2; ++n) _Pragma("unroll") for (int k = 0; k < 2; ++k) dst[n][k] = *(const LAS bf16x8*)(lds + PG8_SB(b, h) + boff + n * 2048 + k * 1024); } while (0)
#define PG8_MMA(ai, bj, At, Bt) do { __builtin_amdgcn_s_setprio(1); _Pragma("unroll") for (int m = 0; m < 4; ++m) _Pragma("unroll") for (int n = 0; n < 2; ++n) _Pragma("unroll") for (int k = 0; k < 2; ++k) \
        acc[ai][bj][m][n] = __builtin_amdgcn_mfma_f32_16x16x32_bf16(Bt[n][k], At[m][k], acc[ai][bj][m][n], 0, 0, 0); __builtin_amdgcn_s_setprio(0); } while (0)
#define PG8_WAIT_V(n) asm volatile("s_waitcnt vmcnt(" #n ")" ::: "memory")
#define PG8_WAIT_L(n) asm volatile("s_waitcnt lgkmcnt(" #n ")" ::: "memory")
#define PG8_BAR __builtin_amdgcn_s_barrier()
#define PG8_SCHED __builtin_amdgcn_sched_barrier(0)
    Unit cur, nxt; int ui = 0;
    if (!S.next(0, cur)) return;
    f32x4 acc[2][2][4][2];
#pragma unroll
    for (int a = 0; a < 2; ++a)
#pragma unroll
        for (int b = 0; b < 2; ++b)
#pragma unroll
            for (int m = 0; m < 4; ++m)
#pragma unroll
                for (int n = 0; n < 2; ++n) acc[a][b][m][n] = (f32x4){0.f, 0.f, 0.f, 0.f};
    bf16x8 At[4][2], B0[2][2], B1[2][2];
    const char* cA = (const char*)g.A + (size_t)cur.pm * tstepA; const char* cB = (const char*)g.Bt + (size_t)cur.pn * tstepB;
    PG8_STAGE(PG8_SB(0, 0), cB, voffB); PG8_STAGE(PG8_SB(0, 1), cB + hstepB, voffB); PG8_STAGE(PG8_SA(0, 0), cA, voffA); PG8_STAGE(PG8_SA(0, 1), cA + hstepA, voffA);
    if (wr == 1) PG8_BAR;
    PG8_WAIT_V(2); PG8_BAR;
    PG8_STAGE(PG8_SB(1, 0), cB + kstep, voffB); PG8_STAGE(PG8_SA(1, 0), cA + kstep, voffA); PG8_STAGE(PG8_SB(1, 1), cB + hstepB + kstep, voffB);
    PG8_WAIT_V(6); PG8_BAR;
    for (;;) {
        const bool has_next = S.next(ui + 1, nxt);
        const char* nA = has_next ? (const char*)g.A + (size_t)nxt.pm * tstepA : cA; const char* nB = has_next ? (const char*)g.Bt + (size_t)nxt.pn * tstepB : cB;
        for (int t = 0; t < nt; t += 2) {
            const bool last = (t == nt - 2);
            const char* a1 = cA + (size_t)(t + 1) * kstep;
            const char* a2 = last ? nA : cA + (size_t)(t + 2) * kstep; const char* b2 = last ? nB : cB + (size_t)(t + 2) * kstep;
            const char* a3 = a2 + kstep; const char* b3 = b2 + kstep;
            PG8_LDB(B0, 0, 0); PG8_LDB(B1, 0, 1); PG8_SCHED; PG8_LDA(At, 0, 0); PG8_STAGE(PG8_SA(1, 1), a1 + hstepA, voffA);
            PG8_WAIT_V(8); PG8_WAIT_L(0); PG8_BAR; PG8_MMA(0, 0, At, B0); PG8_MMA(0, 1, At, B1); PG8_BAR; PG8_SCHED;
            PG8_LDA(At, 0, 1); PG8_STAGE(PG8_SB(0, 0), b2, voffB); PG8_STAGE(PG8_SB(0, 1), b2 + hstepB, voffB); PG8_STAGE(PG8_SA(0, 0), a2, voffA);
            PG8_WAIT_V(8); PG8_WAIT_L(0); PG8_BAR; PG8_MMA(1, 0, At, B0); PG8_MMA(1, 1, At, B1); PG8_BAR; PG8_SCHED;
            PG8_LDB(B0, 1, 0); PG8_LDB(B1, 1, 1); PG8_SCHED; PG8_LDA(At, 1, 0); PG8_STAGE(PG8_SA(0, 1), a2 + hstepA, voffA);
            PG8_WAIT_V(8); PG8_WAIT_L(0); PG8_BAR; PG8_MMA(0, 0, At, B0); PG8_MMA(0, 1, At, B1); PG8_BAR; PG8_SCHED;
            PG8_LDA(At, 1, 1); PG8_STAGE(PG8_SB(1, 0), b3, voffB); PG8_STAGE(PG8_SB(1, 1), b3 + hstepB, voffB); PG8_STAGE(PG8_SA(1, 0), a3, voffA);
            PG8_WAIT_V(8); PG8_WAIT_L(0); PG8_BAR; PG8_MMA(1, 0, At, B0); PG8_MMA(1, 1, At, B1); PG8_BAR; PG8_SCHED;
        }
        if (wr == 0) PG8_BAR;
        { const Epi E = load_epi(Ep); E(acc, cur, wr, wc, fr, fq); }
        if (!has_next) break;
#pragma unroll
        for (int a = 0; a < 2; ++a)
#pragma unroll
            for (int b = 0; b < 2; ++b)
#pragma unroll
                for (int m = 0; m < 4; ++m)
#pragma unroll
                    for (int n = 0; n < 2; ++n) acc[a][b][m][n] = (f32x4){0.f, 0.f, 0.f, 0.f};
        cur = nxt; cA = nA; cB = nB; ++ui;
        if (wr == 1) PG8_BAR;
    }
    PG8_WAIT_V(0);
    PG8_BAR;
#undef PG8_SA
#undef PG8_SB
#undef PG8_STAGE
#undef PG8_LDA
#undef PG8_LDB
#undef PG8_MMA
#undef PG8_WAIT_V
#undef PG8_WAIT_L
#undef PG8_BAR
#undef PG8_SCHED
}
}

__device__ __forceinline__ void tr_item(const float* __restrict__ W, int K, int Nsrc, int col0, int nvalid, const float* __restrict__ gain, bf16_t* WT, int drow0, int k0, LAS float* scr, int lane) {
    float v[32];
#pragma unroll
    for (int i = 0; i < 32; ++i) { const int kk = 2 * i + (lane >> 5), n = lane & 31; v[i] = 0.f; if (n < nvalid) v[i] = W[(size_t)(k0 + kk) * Nsrc + col0 + n]; }
#pragma unroll
    for (int i = 0; i < 32; ++i) { const int kk = 2 * i + (lane >> 5), n = lane & 31; float x = v[i]; if (gain) x *= gain[k0 + kk]; scr[kk * 33 + n] = x; }
    const int c = lane & 7;
#pragma unroll
    for (int j = 0; j < 4; ++j) { const int n = (lane >> 3) + 8 * j; const LAS float* s = scr + (8 * c) * 33 + n;
        u32x4 o; o.x = pk2(s[0 * 33], s[1 * 33]); o.y = pk2(s[2 * 33], s[3 * 33]); o.z = pk2(s[4 * 33], s[5 * 33]); o.w = pk2(s[6 * 33], s[7 * 33]);
        *(u32x4*)(WT + (size_t)(drow0 + n) * K + k0 + 8 * c) = o; }
}
__device__ __forceinline__ void conv_job(int kind, const float* W, const float* W2, int K, int Nsrc, int Ndst, const float* gain, bf16_t* WT, LAS float* scr, int gw, int NGW, int lane) {
    const int nb = Ndst / 32, nitems = (K / 64) * nb;
    for (int it = gw; it < nitems; it += NGW) {
        const int kb = it / nb, db = it % nb, d0 = db * 32, k0 = kb * 64; const float* src = W; int col0 = d0, nvalid = 32;
        if (kind == 1) { const int t = d0 >> 8; int r = d0 & 255; if (r >= 128) { src = W2; r -= 128; } col0 = t * 128 + r; }
        else if (kind == 2) { if (d0 < 7168) col0 = d0; else if (d0 < 11264) col0 = d0 + 16; else if (d0 == 11264) { col0 = 7168; nvalid = 16; } else { col0 = 0; nvalid = 0; } }
        tr_item(src, K, Nsrc, col0, nvalid, gain, WT, d0, k0, scr, lane);
    }
}
__device__ __forceinline__ void rows_to_bf16(const float* X, bf16_t* XB, float* ssqf, u64* ssqx, int nrows, int gw, int NGW, int lane) {
    for (int row = gw; row < nrows; row += NGW) {
        const f32x4* p = (const f32x4*)(X + (size_t)row * DM) + lane; f32x4 v[8]; float ss = 0.f;
#pragma unroll
        for (int j = 0; j < 8; ++j) { v[j] = p[64 * j]; ss += (v[j].x * v[j].x + v[j].y * v[j].y) + (v[j].z * v[j].z + v[j].w * v[j].w); }
        ss = wave_sum(ss); if (lane == 0) { if (ssqf) ssqf[row] = ss; else ssqx[row] = ssq_fix(ss); }
        u32x2* o = (u32x2*)(XB + (size_t)row * DM) + lane;
#pragma unroll
        for (int j = 0; j < 8; ++j) { u32x2 w; w.x = pk2(v[j].x, v[j].y); w.y = pk2(v[j].z, v[j].w); o[64 * j] = w; }
    }
}

constexpr int AT_KS = 0, AT_VS = 34816, AT_KM = 71680, AT_SC = 79872, AT_SEL = 88064, AT_LUT = 88576, AT_PITCH = 272, AT_VP = 288;
template <bool MOBA>
__device__ __forceinline__ void attn_unit(LAS unsigned char* lds, const bf16_t* Qp, int ldq, const bf16_t* Kp, const bf16_t* Vp, int ldkv, bf16_t* Op, int ldo, int qt, const float* kmean, const float* relb, const int tid) {
    const int w = __builtin_amdgcn_readfirstlane(tid >> 6), lane = tid & 63, l15 = lane & 15, quad = lane >> 4;
    const int own = qt >> 1;
    const float L2E = 1.4426950408889634f;
    bf16x8 qf[4]; unsigned mysel = 0u, wave_mask = 0u;
    lds_barrier();
    if (MOBA) {
#pragma unroll
        for (int i = 0; i < 4; ++i) { const int id = tid + 512 * i, r = id >> 4, c = id & 15; *(LAS u32x4*)(lds + AT_KS + r * AT_PITCH + c * 16) = *(const u32x4*)(Qp + (size_t)r * ldq + c * 8); }
        for (int i = tid; i < own * 128; i += 512) { const float* kp = kmean + (size_t)(i >> 7) * 512 + (i & 127); ((LAS float*)(lds + AT_KM))[i] = (kp[0] + kp[128]) + (kp[256] + kp[384]); }
        if (tid < 128) { const int n = tid; int bk = n; if (n >= 16) { bk = 16 + (int)(logf((float)n / 16.f) / 2.0794415416798357f * 16.f); if (bk > 31) bk = 31; } ((LAS float*)(lds + AT_LUT))[tid] = relb[bk * 8] * L2E; }
        lds_barrier();
        { const int q = tid & 127, jg = tid >> 7;
          for (int j = jg; j < own; j += 4) { float d = 0.f; const LAS float* km = (const LAS float*)(lds + AT_KM) + j * 128;
#pragma unroll 4
              for (int c = 0; c < 16; ++c) { const u32x4 qv = *(const LAS u32x4*)(lds + AT_KS + q * AT_PITCH + c * 16); const f32x4 k0 = *(const LAS f32x4*)(km + c * 8), k1 = *(const LAS f32x4*)(km + c * 8 + 4);
                  d += bflo(qv.x) * k0.x + bfhi(qv.x) * k0.y + bflo(qv.y) * k0.z + bfhi(qv.y) * k0.w + bflo(qv.z) * k1.x + bfhi(qv.z) * k1.y + bflo(qv.w) * k1.z + bfhi(qv.w) * k1.w; }
              ((LAS float*)(lds + AT_SC))[q * 16 + j] = d; } }
        lds_barrier();
        if (tid < 128) { unsigned mask = 0u;
            if (own <= 3) mask = (1u << own) - 1u;
            else { const LAS float* sc = (const LAS float*)(lds + AT_SC) + tid * 16;
                for (int r = 0; r < 3; ++r) { float best = -INFINITY; int bi = 0; for (int j = 0; j < own; ++j) { const float v = sc[j]; if (!((mask >> j) & 1u) && v > best) { best = v; bi = j; } } mask |= 1u << bi; } }
            ((LAS unsigned*)(lds + AT_SEL))[tid] = mask; }
        lds_barrier();
#pragma unroll
        for (int s = 0; s < 4; ++s) qf[s] = *(const LAS bf16x8*)(lds + AT_KS + (w * 16 + l15) * AT_PITCH + (quad * 8 + 32 * s) * 2);
        mysel = ((LAS unsigned*)(lds + AT_SEL))[w * 16 + l15];
        { unsigned m = mysel; m |= __shfl_xor(m, 1); m |= __shfl_xor(m, 2); m |= __shfl_xor(m, 4); m |= __shfl_xor(m, 8); wave_mask = __builtin_amdgcn_readfirstlane(m); }
    } else {
#pragma unroll
        for (int s = 0; s < 4; ++s) qf[s] = *(const bf16x8*)(Qp + (size_t)(w * 16 + l15) * ldq + quad * 8 + 32 * s);
    }
    f32x4 oacc[8]; float mrow = -INFINITY, lrow = 0.f;
#pragma unroll
    for (int n = 0; n < 8; ++n) oacc[n] = (f32x4){0.f, 0.f, 0.f, 0.f};
    const int nhalf = MOBA ? own * 2 + (qt & 1) + 1 : 2;
    const float sc2 = 0.08838834764831845f * L2E;
    u32x4 kreg[4], vreg[4];
#pragma unroll
    for (int i = 0; i < 4; ++i) { const int id = tid + 512 * i, r = id >> 4, c = id & 15; kreg[i] = *(const u32x4*)(Kp + (size_t)r * ldkv + c * 8); vreg[i] = *(const u32x4*)(Vp + (size_t)r * ldkv + c * 8); }
#pragma unroll 1
    for (int hi = 0; hi < nhalf; ++hi) {
        const int j = hi >> 1, kr0 = hi * 128;
        lds_barrier();
#pragma unroll
        for (int i = 0; i < 4; ++i) { const int id = tid + 512 * i, r = id >> 4, c = id & 15;
            *(LAS u32x4*)(lds + AT_KS + r * AT_PITCH + c * 16) = kreg[i]; *(LAS u32x4*)(lds + AT_VS + r * AT_VP + c * 16) = vreg[i]; }
        lds_barrier();
        if (hi + 1 < nhalf) {
#pragma unroll
            for (int i = 0; i < 4; ++i) { const int id = tid + 512 * i, r = id >> 4, c = id & 15; kreg[i] = *(const u32x4*)(Kp + (size_t)(kr0 + 128 + r) * ldkv + c * 8); vreg[i] = *(const u32x4*)(Vp + (size_t)(kr0 + 128 + r) * ldkv + c * 8); }
        }
        const bool active = !MOBA || j == own || ((wave_mask >> j) & 1u);
        if (active) {
            f32x4 sacc[8];
#pragma unroll
            for (int kt = 0; kt < 8; ++kt) { sacc[kt] = (f32x4){0.f, 0.f, 0.f, 0.f};
#pragma unroll
                for (int s = 0; s < 4; ++s) { const bf16x8 kf = *(const LAS bf16x8*)(lds + AT_KS + (kt * 16 + l15) * AT_PITCH + (quad * 8 + 32 * s) * 2); sacc[kt] = __builtin_amdgcn_mfma_f32_16x16x32_bf16(kf, qf[s], sacc[kt], 0, 0, 0); }
                if (kt & 1) __builtin_amdgcn_sched_barrier(0); }
            float mx = -INFINITY; float ps = 0.f;
            bool simple = !MOBA; float cbm = 0.f;
            bool lsel = true;
            if (MOBA) {
                const bool farb = (qt * 128 + w * 16) - (kr0 + 127) >= 127;
                lsel = (j == own) || ((mysel >> j) & 1u);
                simple = farb; cbm = lsel ? ((const LAS float*)(lds + AT_LUT))[127] : -INFINITY;
            }
            if (simple) {
#pragma unroll
                for (int kt = 0; kt < 8; ++kt)
#pragma unroll
                    for (int i = 0; i < 4; ++i) mx = fmaxf(mx, sacc[kt][i]);
                mx = mx * sc2 + cbm;
            } else {
                const int qpos = qt * 128 + w * 16 + l15, kpos0 = kr0 + quad * 4;
#pragma unroll
                for (int kt = 0; kt < 8; ++kt)
#pragma unroll
                    for (int i = 0; i < 4; ++i) { const int rel = qpos - (kpos0 + kt * 16 + i);
                        const int ri = rel < 0 ? 0 : (rel > 127 ? 127 : rel); const float b = ((const LAS float*)(lds + AT_LUT))[ri];
                        const bool valid = (j == own) ? (rel >= 0) : lsel;
                        const float sv = valid ? sacc[kt][i] * sc2 + b : -INFINITY; sacc[kt][i] = sv; mx = fmaxf(mx, sv); }
            }
            mx = fmaxf(mx, __shfl_xor(mx, 16)); mx = fmaxf(mx, __shfl_xor(mx, 32));
            const float mn = fmaxf(mrow, mx), mu = (mn == -INFINITY) ? 0.f : mn, alpha = __builtin_amdgcn_exp2f(mrow - mu);
            const bool moved = mn != mrow; mrow = mn;
            if (simple) { const float off = cbm - mu;
#pragma unroll
                for (int kt = 0; kt < 8; ++kt)
#pragma unroll
                    for (int i = 0; i < 4; ++i) { const float p = __builtin_amdgcn_exp2f(sacc[kt][i] * sc2 + off); sacc[kt][i] = p; ps += p; }
            } else {
#pragma unroll
                for (int kt = 0; kt < 8; ++kt)
#pragma unroll
                    for (int i = 0; i < 4; ++i) { const float p = __builtin_amdgcn_exp2f(sacc[kt][i] - mu); sacc[kt][i] = p; ps += p; }
            }
            lrow = lrow * alpha + ps;
            if (__builtin_amdgcn_ballot_w64(moved) != 0ull) {
#pragma unroll
                for (int n = 0; n < 8; ++n) oacc[n] = oacc[n] * alpha;
            }
            const int r4 = l15 >> 2, c4 = l15 & 3;
#pragma unroll
            for (int s = 0; s < 4; ++s) {
                union { u32x4 u; bf16x8 b; } pf;
                pf.u.x = pk2(sacc[2 * s][0], sacc[2 * s][1]); pf.u.y = pk2(sacc[2 * s][2], sacc[2 * s][3]); pf.u.z = pk2(sacc[2 * s + 1][0], sacc[2 * s + 1][1]); pf.u.w = pk2(sacc[2 * s + 1][2], sacc[2 * s + 1][3]);
#pragma unroll
                for (int n = 0; n < 8; ++n) {
                    LAS unsigned char* va = lds + AT_VS + (32 * s + quad * 4 + r4) * AT_VP + (n * 16 + 4 * c4) * 2;
                    const s16x4 lo = __builtin_amdgcn_ds_read_tr16_b64_v4i16((LAS s16x4*)va);
                    const s16x4 hi4 = __builtin_amdgcn_ds_read_tr16_b64_v4i16((LAS s16x4*)(va + 16 * AT_VP));
                    const bf16x8 vf = {lo[0], lo[1], lo[2], lo[3], hi4[0], hi4[1], hi4[2], hi4[3]};
                    oacc[n] = __builtin_amdgcn_mfma_f32_16x16x32_bf16(vf, pf.b, oacc[n], 0, 0, 0);
                }
                __builtin_amdgcn_sched_barrier(0);
            }
        }
    }
    lrow += __shfl_xor(lrow, 16); lrow += __shfl_xor(lrow, 32);
    const float inv = 1.f / lrow;
#pragma unroll
    for (int n = 0; n < 8; ++n) { u32x2 o; o.x = pk2(oacc[n][0] * inv, oacc[n][1] * inv); o.y = pk2(oacc[n][2] * inv, oacc[n][3] * inv);
        *(u32x2*)(Op + (size_t)(w * 16 + l15) * ldo + n * 16 + quad * 4) = o; }
}

constexpr int GL_Q = 0, GL_K = 33792, GL_V = 67584, GL_M = 100352, GL_SM = 116736, GL_QB = 118784, GL_KB = 136192;
struct GdnP { bf16_t* proj; const bf16_t* halo; const float* baf; const float* conv; const float* a_log; const float* dt_bias; bf16_t* wbuf; bf16_t* attnb; float* cdb; float* rstdo; };
__device__ __forceinline__ void gdn_local_unit(LAS unsigned char* lds, const GdnP& P, int unit, const int tid, const int pf) {
    const int w = __builtin_amdgcn_readfirstlane(tid >> 6), lane = tid & 63, l15 = lane & 15, quad = lane >> 4;
    const int h = unit & 7, cn = unit >> 3, n = cn & 63, row0 = cn * 64;
    LAS float* Qs = (LAS float*)vbase(lds + GL_Q); LAS float* Ks = (LAS float*)vbase(lds + GL_K); LAS float* Vs = (LAS float*)vbase(lds + GL_V); LAS float* Ms = (LAS float*)vbase(lds + GL_M);
    LAS float* rq = (LAS float*)vbase(lds + GL_SM); LAS float* rk = rq + 64; LAS float* beta = rq + 128; LAS float* Gc = rq + 192; LAS float* eG = rq + 256; LAS float* gb = rq + 320;
    lds_barrier();
    if (tid < 384 && !(pf & 32)) {
        const int c8 = tid & 15, which = (tid >> 4) % 3, tseg = tid / 48, t0 = tseg * 8, col = which * 1024 + h * 128 + c8 * 8;
        float wg[4][8];
#pragma unroll
        for (int i = 0; i < 4; ++i) { const f32x4 w0 = *(const f32x4*)(P.conv + i * 3072 + col), w1 = *(const f32x4*)(P.conv + i * 3072 + col + 4);
            wg[i][0] = w0.x; wg[i][1] = w0.y; wg[i][2] = w0.z; wg[i][3] = w0.w; wg[i][4] = w1.x; wg[i][5] = w1.y; wg[i][6] = w1.z; wg[i][7] = w1.w; }
        u32x4 raw[11];
#pragma unroll
        for (int r = 0; r < 11; ++r) { const int tt = t0 - 3 + r; raw[r] = (u32x4){0u, 0u, 0u, 0u};
            if (tt >= 0) raw[r] = *(const u32x4*)(P.proj + (size_t)(row0 + tt) * NIN + C_GDN + col);
            else if (n > 0) raw[r] = *(const u32x4*)(P.halo + ((size_t)(cn - 1) * 3 + (tt + 3)) * 3072 + col); }
#pragma unroll
        for (int r = 0; r < 8; ++r) { float a[8] = {0.f, 0.f, 0.f, 0.f, 0.f, 0.f, 0.f, 0.f};
#pragma unroll
            for (int i = 0; i < 4; ++i) { const u32x4 rv = raw[r + i];
                a[0] += wg[i][0] * bflo(rv.x); a[1] += wg[i][1] * bfhi(rv.x); a[2] += wg[i][2] * bflo(rv.y); a[3] += wg[i][3] * bfhi(rv.y);
                a[4] += wg[i][4] * bflo(rv.z); a[5] += wg[i][5] * bfhi(rv.z); a[6] += wg[i][6] * bflo(rv.w); a[7] += wg[i][7] * bfhi(rv.w); }
#pragma unroll
            for (int e = 0; e < 8; ++e) a[e] = a[e] * sigmoidf_(a[e]);
            const int t = t0 + r;
            LAS float* dst = (which == 0 ? Qs + t * 132 : (which == 1 ? Ks + t * 132 : Vs + t * 128)) + c8 * 8;
            *(LAS f32x4*)dst = (f32x4){a[0], a[1], a[2], a[3]}; *(LAS f32x4*)(dst + 4) = (f32x4){a[4], a[5], a[6], a[7]}; }
    }
    lds_barrier();
    if (tid < 128) { const int r = tid & 63; const LAS float* arr = (tid < 64 ? Qs : Ks) + r * 132; float ss = 0.f;
#pragma unroll 8
        for (int c = 0; c < 32; ++c) { const f32x4 v = *(const LAS f32x4*)(arr + 4 * c); ss += (v.x * v.x + v.y * v.y) + (v.z * v.z + v.w * v.w); }
        const float rn = 1.f / sqrtf(ss + EPS); if (tid < 64) rq[r] = rn * 0.08838834764831845f; else rk[r] = rn; }
    else if (tid < 192) { const int t = tid - 128; const float bl = P.baf[(size_t)(row0 + t) * 16 + h], al = P.baf[(size_t)(row0 + t) * 16 + 8 + h];
        beta[t] = 1.f / (1.f + expf(-bl)); const float x = al + P.dt_bias[h]; const float sp = x > 20.f ? x : log1pf(expf(x)); gb[t] = -expf(P.a_log[h]) * sp; }
    lds_barrier();
    if (tid < 64) { float v = gb[tid];
#pragma unroll
        for (int o = 1; o < 64; o <<= 1) { const float y = __shfl_up(v, o); if (lane >= o) v += y; }
        Gc[tid] = v; eG[tid] = expf(v); }
    for (int it = tid; it < 2048; it += 512) { const int which = it >> 10, rem = it & 1023, t = rem >> 4, c8 = rem & 15; const LAS float* src = (which ? Ks : Qs) + t * 132 + c8 * 8; const float r = which ? rk[t] : rq[t];
        const f32x4 v0 = *(const LAS f32x4*)src, v1 = *(const LAS f32x4*)(src + 4); u32x4 o; o.x = pk2(v0.x * r, v0.y * r); o.y = pk2(v0.z * r, v0.w * r); o.z = pk2(v1.x * r, v1.y * r); o.w = pk2(v1.z * r, v1.w * r);
        *(LAS u32x4*)(lds + (which ? GL_KB : GL_QB) + t * 272 + c8 * 16) = o; }
    lds_barrier();
    { const int mt = w & 3; const bool isq = w >= 4; const int abase = isq ? GL_QB : GL_KB;
      bf16x8 af[4];
#pragma unroll
      for (int s = 0; s < 4; ++s) af[s] = *(const LAS bf16x8*)(lds + abase + (mt * 16 + l15) * 272 + (quad * 8 + 32 * s) * 2);
      for (int nt = 0; nt < 4; ++nt) {
          f32x4 acc = (f32x4){0.f, 0.f, 0.f, 0.f};
          if (nt <= mt) {
#pragma unroll
              for (int s = 0; s < 4; ++s) { const bf16x8 bfr = *(const LAS bf16x8*)(lds + GL_KB + (nt * 16 + l15) * 272 + (quad * 8 + 32 * s) * 2); acc = __builtin_amdgcn_mfma_f32_16x16x32_bf16(af[s], bfr, acc, 0, 0, 0); }
          }
          const int j = nt * 16 + l15;
#pragma unroll
          for (int i = 0; i < 4; ++i) { const int c = mt * 16 + quad * 4 + i; const float dec = __expf(Gc[c] - Gc[j]);
              if (!isq) Ms[c * 64 + j] = (c > j) ? acc[i] * beta[c] * dec : 0.f;
              else P.attnb[(size_t)unit * 4096 + c * 64 + j] = (bf16_t)f2bf((c >= j) ? acc[i] * dec : 0.f); }
      } }
    lds_barrier();
    if (tid < 256 && !(pf & 2)) {
        const int col = tid; f32x2 sol2[32];
        if (col < 128) {
#pragma unroll
            for (int t = 0; t < 64; ++t) sol2[t >> 1][t & 1] = Vs[t * 128 + col] * beta[t];
        } else {
#pragma unroll
            for (int t = 0; t < 64; ++t) sol2[t >> 1][t & 1] = Ks[t * 132 + col - 128] * rk[t] * beta[t] * eG[t];
        }
#pragma unroll
        for (int c = 1; c < 64; ++c) { f32x2 sp = (f32x2){sol2[c >> 1][c & 1], 0.f};
#pragma unroll
            for (int jb = 0; jb <= (c - 1) / 4; ++jb) { const f32x4 m4 = *(const LAS f32x4*)(Ms + c * 64 + 4 * jb);
                sp -= (f32x2){m4.x, m4.y} * sol2[2 * jb]; sp -= (f32x2){m4.z, m4.w} * sol2[2 * jb + 1]; }
            sol2[c >> 1][c & 1] = sp.x + sp.y; }
        if (col < 128) {
#pragma unroll
            for (int t = 0; t < 64; ++t) Vs[t * 128 + col] = sol2[t >> 1][t & 1];
        } else {
#pragma unroll
            for (int t = 0; t < 64; ++t) *(LAS bf16_t*)(lds + GL_QB + t * 272 + (col - 128) * 2) = (bf16_t)f2bf(sol2[t >> 1][t & 1]);
        }
    } else if (tid >= 256) {
        const int t2 = tid - 256; const float GL = Gc[63];
        for (int it = t2; it < 1024; it += 256) { const int t = it >> 4, c8 = it & 15; const float r = rq[t] * eG[t]; const LAS float* src = Qs + t * 132 + c8 * 8;
            const f32x4 v0 = *(const LAS f32x4*)src, v1 = *(const LAS f32x4*)(src + 4); u32x4 o; o.x = pk2(v0.x * r, v0.y * r); o.y = pk2(v0.z * r, v0.w * r); o.z = pk2(v1.x * r, v1.y * r); o.w = pk2(v1.z * r, v1.w * r);
            *(u32x4*)(P.proj + (size_t)(row0 + t) * NIN + C_GDN + h * 128 + c8 * 8) = o; }
        for (int it = t2; it < 1024; it += 256) { const int kidx = it & 127, t8 = it >> 7; float v[8];
#pragma unroll
            for (int e = 0; e < 8; ++e) { const int t = t8 * 8 + e; v[e] = Ks[t * 132 + kidx] * rk[t] * __expf(GL - Gc[t]); }
            u32x4 o; o.x = pk2(v[0], v[1]); o.y = pk2(v[2], v[3]); o.z = pk2(v[4], v[5]); o.w = pk2(v[6], v[7]);
            *(u32x4*)(P.proj + (size_t)(row0 + (kidx >> 1)) * NIN + C_GDN + 1024 + h * 128 + (kidx & 1) * 64 + t8 * 8) = o; }
        if (t2 == 0) P.cdb[unit] = expf(GL);
    }
    lds_barrier();
    for (int it = tid; it < 1024; it += 512) { const int t = it >> 4, c8 = it & 15;
        const int half = it & 1, ln = (it >> 1) & 63, nh2 = (it >> 7) & 1, mt2 = it >> 8, ql = ln >> 4, ll = ln & 15; float uvv[8];
#pragma unroll
        for (int e = 0; e < 8; ++e) uvv[e] = Vs[(mt2 * 16 + ql * 4 + (e & 3)) * 128 + (4 * nh2 + 2 * half + (e >> 2)) * 16 + ll];
        u32x4 o; o.x = pk2(uvv[0], uvv[1]); o.y = pk2(uvv[2], uvv[3]); o.z = pk2(uvv[4], uvv[5]); o.w = pk2(uvv[6], uvv[7]);
        *(u32x4*)(P.proj + (size_t)(row0 + t) * NIN + C_GDN + 2048 + h * 128 + c8 * 8) = o;
        *(u32x4*)(P.wbuf + (size_t)unit * 8192 + t * 128 + c8 * 8) = *(const LAS u32x4*)(lds + GL_QB + t * 272 + c8 * 16); }
}

constexpr int GC_ST = 0, GC_VT = 34816, GC_RED = 53248, GC_ON = 53760, GC_OB = 54272;
struct ChainOps { bf16x8 wf[4], qf[4], af[2], kf[2]; u32x4 uf[2]; float cd; };
__device__ __forceinline__ void chain_load(ChainOps& o, const GdnP& P, int b, int h, int n, int w, int mt, int nh, int lane, int tid) {
    const int l15 = lane & 15, quad = lane >> 4;
    const int cn = b * 64 + n, unit = cn * 8 + h, row0 = cn * 64;
    const bf16_t* wrow = P.wbuf + (size_t)unit * 8192 + (mt * 16 + l15) * 128 + quad * 8;
    const bf16_t* qrow = P.proj + (size_t)(row0 + mt * 16 + l15) * NIN + C_GDN + h * 128 + quad * 8;
#pragma unroll
    for (int s = 0; s < 4; ++s) { o.wf[s] = *(const bf16x8*)(wrow + 32 * s); o.qf[s] = *(const bf16x8*)(qrow + 32 * s); }
    const bf16_t* arow = P.attnb + (size_t)unit * 4096 + (mt * 16 + l15) * 64 + quad * 8;
    const int kidx = w * 16 + l15;
    const bf16_t* krow = P.proj + (size_t)(row0 + (kidx >> 1)) * NIN + C_GDN + 1024 + h * 128 + (kidx & 1) * 64 + quad * 8;
#pragma unroll
    for (int s = 0; s < 2; ++s) { o.af[s] = *(const bf16x8*)(arow + 32 * s); o.kf[s] = *(const bf16x8*)(krow + 32 * s); }
    o.cd = P.cdb[unit];
    const int cb = ((mt * 2 + nh) * 64 + lane) * 2;
    const bf16_t* up = P.proj + (size_t)(row0 + (cb >> 4)) * NIN + C_GDN + 2048 + h * 128 + (cb & 15) * 8;
    o.uf[0] = *(const u32x4*)up; o.uf[1] = *(const u32x4*)(up + 8);
}
__device__ __forceinline__ void gdn_chain(LAS unsigned char* lds, const GdnP& P, const float* out_norm, int bh, const int tid) {
    const int w = __builtin_amdgcn_readfirstlane(tid >> 6), lane = tid & 63, l15 = lane & 15, quad = lane >> 4;
    const int b = bh >> 3, h = bh & 7, mt = w & 3, nh = w >> 2;
    f32x4 sacc[8];
#pragma unroll
    for (int n = 0; n < 8; ++n) sacc[n] = (f32x4){0.f, 0.f, 0.f, 0.f};
    lds_barrier();
    for (int i = tid; i < 34816 / 16; i += 512) *(LAS u32x4*)(lds + GC_ST + i * 16) = (u32x4){0u, 0u, 0u, 0u};
    ChainOps cur, nxt;
    chain_load(cur, P, b, h, 0, w, mt, nh, lane, tid);
    lds_barrier();
    for (int n = 0; n < 64; ++n) {
        const int row0 = (b * 64 + n) * 64;
        chain_load(nxt, P, b, h, n < 63 ? n + 1 : n, w, mt, nh, lane, tid);
        f32x4 oacc[4];
#pragma unroll
        for (int q = 0; q < 4; ++q) { const int nt = 4 * nh + q; f32x4 a1 = (f32x4){0.f, 0.f, 0.f, 0.f}; oacc[q] = (f32x4){0.f, 0.f, 0.f, 0.f};
#pragma unroll
            for (int s = 0; s < 4; ++s) { const bf16x8 sf = *(const LAS bf16x8*)(lds + GC_ST + (nt * 16 + l15) * 272 + (quad * 8 + 32 * s) * 2);
                a1 = __builtin_amdgcn_mfma_f32_16x16x32_bf16(cur.wf[s], sf, a1, 0, 0, 0); oacc[q] = __builtin_amdgcn_mfma_f32_16x16x32_bf16(cur.qf[s], sf, oacc[q], 0, 0, 0); }
            const unsigned u01 = cur.uf[q >> 1][(q & 1) * 2], u23 = cur.uf[q >> 1][(q & 1) * 2 + 1];
            u32x2 pv; pv.x = pk2(bflo(u01) - a1[0], bfhi(u01) - a1[1]); pv.y = pk2(bflo(u23) - a1[2], bfhi(u23) - a1[3]);
            *(LAS u32x2*)(lds + GC_VT + (nt * 16 + l15) * 144 + (mt * 16 + quad * 4) * 2) = pv; }
        lds_barrier();
        float ss[4] = {0.f, 0.f, 0.f, 0.f};
#pragma unroll
        for (int q = 0; q < 4; ++q) { const int nt = 4 * nh + q;
#pragma unroll
            for (int s = 0; s < 2; ++s) { const bf16x8 vf = *(const LAS bf16x8*)(lds + GC_VT + (nt * 16 + l15) * 144 + (quad * 8 + 32 * s) * 2); oacc[q] = __builtin_amdgcn_mfma_f32_16x16x32_bf16(cur.af[s], vf, oacc[q], 0, 0, 0); }
#pragma unroll
            for (int i = 0; i < 4; ++i) { ss[i] += oacc[q][i] * oacc[q][i]; *(LAS bf16_t*)(lds + GC_OB + (mt * 16 + quad * 4 + i) * 272 + (nt * 16 + l15) * 2) = (bf16_t)f2bf(oacc[q][i]); } }
#pragma unroll
        for (int nt = 0; nt < 8; ++nt) { sacc[nt] = sacc[nt] * cur.cd;
#pragma unroll
            for (int s = 0; s < 2; ++s) { const bf16x8 vf = *(const LAS bf16x8*)(lds + GC_VT + (nt * 16 + l15) * 144 + (quad * 8 + 32 * s) * 2); sacc[nt] = __builtin_amdgcn_mfma_f32_16x16x32_bf16(cur.kf[s], vf, sacc[nt], 0, 0, 0); }
            u32x2 pv; pv.x = pk2(sacc[nt][0], sacc[nt][1]); pv.y = pk2(sacc[nt][2], sacc[nt][3]);
            *(LAS u32x2*)(lds + GC_ST + (nt * 16 + l15) * 272 + (w * 16 + quad * 4) * 2) = pv; }
#pragma unroll
        for (int i = 0; i < 4; ++i) { float s = ss[i]; s += __shfl_xor(s, 1); s += __shfl_xor(s, 2); s += __shfl_xor(s, 4); s += __shfl_xor(s, 8); if (l15 == 0) ((LAS float*)(lds + GC_RED))[(mt * 16 + quad * 4 + i) * 2 + nh] = s; }
        lds_barrier();
        { const int t = tid >> 3, c16 = tid & 7;
          bf16_t* op = P.proj + (size_t)(row0 + t) * NIN + C_GDN + 2048 + h * 128 + c16 * 16;
          *(u32x4*)op = *(const LAS u32x4*)(lds + GC_OB + t * 272 + c16 * 32); *(u32x4*)(op + 8) = *(const LAS u32x4*)(lds + GC_OB + t * 272 + c16 * 32 + 16);
          if (c16 == 0) { const float tot = ((LAS float*)(lds + GC_RED))[t * 2] + ((LAS float*)(lds + GC_RED))[t * 2 + 1]; P.rstdo[(size_t)(row0 + t) * 8 + h] = __builtin_amdgcn_rsqf(tot * (1.f / 128.f) + EPS); } }
        cur = nxt;
    }
}

#define XB_TMO      128
#define XB_XCNT(j)  (256  + 64 * (j))
#define XB_XSUB(j)  (1280 + 64 * (j))
#define XB_XGEN(j)  (2304 + 64 * (j))
#define XB_TOP      3328
#define XB_TOPGEN   3392
#define XCD_BAR_WORDS 3456
#define XB_SPIN_CAP (1u << 18)

__device__ __forceinline__ unsigned xb_ld(unsigned* p)              { return __hip_atomic_load(p, __ATOMIC_RELAXED, __HIP_MEMORY_SCOPE_AGENT); }
__device__ __forceinline__ unsigned xb_add(unsigned* p, unsigned v) { return __hip_atomic_fetch_add(p, v, __ATOMIC_RELAXED, __HIP_MEMORY_SCOPE_AGENT); }
__device__ __forceinline__ unsigned xb_xcc_id() { return (unsigned)__builtin_amdgcn_s_getreg((3 << 11) | 20) & 0xFu; }
#define XB_SPIN(cond, bar) do { unsigned _sp = 0; while (cond) { __builtin_amdgcn_s_sleep(1); \
    if ((++_sp & 255u) == 0u) { if (xb_ld(&(bar)[XB_TMO])) break; if (_sp > XB_SPIN_CAP) { atomicAdd(&(bar)[XB_TMO], 1u); break; } } } } while (0)

struct XcdBarrier {
    unsigned* bar; unsigned x;
    volatile LAS unsigned* st;
};

__device__ __forceinline__ XcdBarrier xcd_barrier_post(unsigned* bar, volatile LAS unsigned* st) {
    XcdBarrier b; b.bar = bar; b.x = xb_xcc_id(); b.st = st;
    if (threadIdx.x == 0) (void)xb_add(&bar[XB_XCNT(b.x)], 1u);
    return b;
}
__device__ __forceinline__ void xcd_barrier_complete(unsigned* bar, unsigned x, unsigned& nloc, unsigned& nx) {
    const unsigned G = gridDim.x * gridDim.y * gridDim.z;
    unsigned sum, cnt, mine, sp = 0u;
    for (;;) {
        sum = 0u; cnt = 0u; mine = 0u;
#pragma unroll
        for (unsigned j = 0; j < 16; ++j) { const unsigned c = xb_ld(&bar[XB_XCNT(j)]); sum += c; cnt += (c > 0u) ? 1u : 0u; mine = (j == x) ? c : mine; }
        if (sum == G) break;
        __builtin_amdgcn_s_sleep(1);
        if ((++sp & 255u) == 0u) { if (xb_ld(&bar[XB_TMO])) break; if (sp > XB_SPIN_CAP) { atomicAdd(&bar[XB_TMO], 1u); break; } }
    }
    nloc = mine > 0u ? mine : 1u; nx = cnt > 0u ? cnt : 1u;
}

__device__ __forceinline__ void xcd_barrier(const XcdBarrier& b) {
    asm volatile("s_waitcnt vmcnt(0)" ::: "memory");
    __syncthreads();
    if (threadIdx.x == 0) {
        unsigned* bar = b.bar;
        __builtin_amdgcn_s_waitcnt(0);
        unsigned nloc = b.st[0], nx = b.st[1];
        if (nloc == 0u) { xcd_barrier_complete(bar, b.x, nloc, nx); b.st[0] = nloc; b.st[1] = nx; }
        const unsigned old = xb_add(&bar[XB_XSUB(b.x)], 1u);
        const unsigned gen = old / nloc;
        if (old + 1u == (gen + 1u) * nloc) {
            __builtin_amdgcn_fence(__ATOMIC_RELEASE, "agent");
            asm volatile("s_waitcnt vmcnt(0)" ::: "memory");
            const unsigned og = xb_add(&bar[XB_TOP], 1u);
            const unsigned tg = og / nx;
            if (og + 1u == (tg + 1u) * nx) xb_add(&bar[XB_TOPGEN], 1u);
            else XB_SPIN(xb_ld(&bar[XB_TOPGEN]) == tg, bar);
            __builtin_amdgcn_fence(__ATOMIC_ACQUIRE, "agent");
            xb_add(&bar[XB_XGEN(b.x)], 1u);
            asm volatile("s_waitcnt vmcnt(0)" ::: "memory");
        } else {
            XB_SPIN(xb_ld(&bar[XB_XGEN(b.x)]) == gen, bar);
            __builtin_amdgcn_fence(__ATOMIC_ACQUIRE, "agent");
            asm volatile("s_waitcnt vmcnt(0)" ::: "memory");
        }
    }
    __syncthreads();
}


enum { P_PRO = 0, P_GU1, P_DOWN1, P_PROJ, P_GDNL, P_MIX, P_GFIN, P_BRANCH, P_WOUT, P_XQ, P_XATT, P_XO, P_GU2, P_DOWN2, P_FINAL, NPHASE };
struct Args { const float* in[26]; float* out; unsigned char* ws; int ph_lo, ph_hi, probe, pad; };
enum { I_X = 0, I_MEM, I_F1N, I_F1G, I_F1U, I_F1D, I_MIXN, I_WIN, I_CONV, I_ALOG, I_DTB, I_ONORM, I_RELB, I_WBA, I_WBD, I_WOUT, I_CN, I_MN, I_WQ, I_WKV, I_WO, I_F2N, I_F2G, I_F2U, I_F2D, I_FN };

#define AIN(k) (a.in[(k) + zs])
#define PHASE_HEAD \
    int zs = 0; asm volatile("" : "+s"(zs)); \
    unsigned char* ws = a.ws + zs; float* ctl = (float*)(ws + WS_CTL); u64* ssqx = (u64*)(ws + WS_CTL); (void)ssqx; \
    bf16_t* proj = (bf16_t*)(ws + WS_PROJ); bf16_t* hb = (bf16_t*)(ws + WS_HB); bf16_t* hff = (bf16_t*)(ws + WS_HFF); \
    int tidL = threadIdx.x; asm volatile("" : "+v"(tidL)); \
    const int tid = tidL, lane = tid & 63, wave = __builtin_amdgcn_readfirstlane(tid >> 6), gw = bx * NWAVES + wave; \
    (void)ctl; (void)proj; (void)hb; (void)hff; (void)lane; (void)gw;
#define GRID_SYNC(k) do { if (lo <= (k) && (k) + 1 < hi) { if (hi > 1000) cg::this_grid().sync(); else xcd_barrier(xbar); } } while (0)

__device__ __forceinline__ void gemm_range(const Args& a, LAS unsigned char* lds, int lo, int hi, int first, int last, int G, int bx, int NGW, const XcdBarrier& xbar) {
    for (int ph = (lo > first ? lo : first); ph <= last && ph < hi; ++ph) {
        PHASE_HEAD
        const int ng = (ph == P_BRANCH || ph == P_XQ) ? 2 : 1;
        for (int gi = 0; gi < ng; ++gi) {
            pg8::Gemm g{}; pg8::Epi E{}; int rot = 0;
            switch (ph) {
            case P_GU1: g = {hb, (const bf16_t*)(ws + WS_WGU), TOK, NGU, DM, DM}; E.mode = pg8::E_GU; E.ssq = ssqx; E.outb = hff; E.ldo = FF; break;
            case P_DOWN1: g = {hff, (const bf16_t*)(ws + WS_WD), TOK, DM, FF, FF}; E.mode = pg8::E_RESID; E.hinb = hb; E.hout = nullptr; E.alpha = 0.5f; E.ssq_out = ssqx + TOK; E.hb = hb; break;
            case P_PROJ: g = {hb, (const bf16_t*)(ws + WS_WIN), TOK, NIN, DM, DM}; E.mode = pg8::E_SCALE; E.ssq = ssqx + TOK; E.outb = proj; E.ldo = NIN; E.halo = (bf16_t*)(ws + WS_HALO); E.baf = (float*)(ws + WS_BAF); break;
            case P_BRANCH:
                if (gi == 0) { g = {proj, (const bf16_t*)(ws + WS_WBA), TOK, DM, 1024, NIN}; E.mode = pg8::E_BR1; }
                else { g = {proj + C_Z, (const bf16_t*)(ws + WS_WBD), TOK, DM, 1024, NIN}; E.mode = pg8::E_BR2; E.gate = proj + C_GB; }
                E.outb = proj + C_GA; E.ldo = NIN; break;
            case P_WOUT: g = {proj + C_GA, (const bf16_t*)(ws + WS_WOUT), TOK, DM, DM, NIN}; E.mode = pg8::E_RESID; E.hinb = hb; E.hout = nullptr; E.alpha = 1.f; E.ssq_out = ssqx + 2 * TOK; E.hb = hb; break;
            case P_XQ:
                if (gi == 0) { g = {hb, (const bf16_t*)(ws + WS_WQ), TOK, 512, DM, DM}; E.ssq = ssqx + 2 * TOK; E.outb = (bf16_t*)(ws + WS_QX); E.ldo = 512; }
                else { g = {(const bf16_t*)(ws + WS_MEMB), (const bf16_t*)(ws + WS_WKV), 1024, 1024, DM, DM}; E.ssqf = ctl + CT_SSQM; E.outb = (bf16_t*)(ws + WS_KVX); E.ldo = 1024; rot = 128; }
                E.mode = pg8::E_SCALE; break;
            case P_XO: g = {(const bf16_t*)(ws + WS_OX), (const bf16_t*)(ws + WS_WO), TOK, DM, 512, 512}; E.mode = pg8::E_RESID; E.hinb = hb; E.hout = nullptr; E.alpha = 1.f; E.ssq_out = ssqx + 3 * TOK; E.hb = hb; break;
            case P_GU2: g = {hb, (const bf16_t*)(ws + WS_WGU), TOK, NGU, DM, DM}; E.mode = pg8::E_GU; E.ssq = ssqx + 3 * TOK; E.outb = hff; E.ldo = FF; break;
            default: g = {hff, (const bf16_t*)(ws + WS_WD), TOK, DM, FF, FF}; E.mode = pg8::E_RESID; E.hinb = hb; E.hout = nullptr; E.alpha = 0.5f; E.ssq_out = ssqx + 4 * TOK; E.hb = hb; break;
            }
            if (a.probe && E.mode == pg8::E_RESID) { if (E.hout) E.hout = (float*)(ws + 389 * MiB); E.ssq_out = (u64*)(ws + 524 * MiB); if (E.hb) E.hb = (bf16_t*)(ws + 38 * MiB); }
            pg8::StaticOrder S; S.init(g.M, g.N, G, (bx + rot) % G);
            __syncthreads();
            if (tid == 0) { LAS pg8::Epi* d = (LAS pg8::Epi*)(lds + 157 * 1024 + 64); d->ssqf = E.ssqf; d->mode = E.mode; d->ssq = E.ssq; d->outb = E.outb; d->ldo = E.ldo; d->hin = E.hin; d->hout = E.hout; d->alpha = E.alpha; d->ssq_out = E.ssq_out; d->hb = E.hb; d->halo = E.halo; d->baf = E.baf; d->gate = E.gate; d->hinb = E.hinb; }
            __syncthreads();
            pg8::gemm_phase(lds, g, S, (const LAS pg8::Epi*)(lds + 157 * 1024 + 64), tid);
            __syncthreads();
        }
        if (ph == P_XQ) {
            LAS float* scr = (LAS float*)(lds + wave * 8704);
            conv_job(1, AIN(I_F2G), AIN(I_F2U), DM, FF, NGU, AIN(I_F2N), (bf16_t*)(ws + WS_WGU), scr, gw, NGW, lane);
            conv_job(0, AIN(I_F2D), nullptr, FF, DM, DM, nullptr, (bf16_t*)(ws + WS_WD), scr, gw, NGW, lane);
        }
        GRID_SYNC(ph);
    }
}

__global__ void __launch_bounds__(NTHREADS, 2) mega(Args a) {
    extern __shared__ __attribute__((aligned(16))) unsigned char lds_raw[];
    LAS unsigned char* lds = (LAS unsigned char*)lds_raw;
    const int G = gridDim.x, bx = blockIdx.x, NGW = G * NWAVES;
    const int lo = a.ph_lo, hi = a.ph_hi;
    if (threadIdx.x < 4) ((LAS unsigned*)(lds + 157 * 1024 + 256))[threadIdx.x] = 0u;
    __syncthreads();
    const XcdBarrier xbar = xcd_barrier_post((unsigned*)(a.ws + WS_BAR) + a.pad * XCD_BAR_WORDS, (volatile LAS unsigned*)(lds + 157 * 1024 + 256));
    if (lo <= P_PRO && P_PRO < hi) {
        PHASE_HEAD
        LAS float* scr = (LAS float*)(lds + wave * 8704);
        conv_job(1, AIN(I_F1G), AIN(I_F1U), DM, FF, NGU, AIN(I_F1N), (bf16_t*)(ws + WS_WGU), scr, gw, NGW, lane);
        conv_job(0, AIN(I_F1D), nullptr, FF, DM, DM, nullptr, (bf16_t*)(ws + WS_WD), scr, gw, NGW, lane);
        conv_job(2, AIN(I_WIN), nullptr, DM, 11280, NIN, AIN(I_MIXN), (bf16_t*)(ws + WS_WIN), scr, gw, NGW, lane);
        conv_job(0, AIN(I_WBA), nullptr, 1024, DM, DM, nullptr, (bf16_t*)(ws + WS_WBA), scr, gw, NGW, lane);
        conv_job(0, AIN(I_WBD), nullptr, 1024, DM, DM, nullptr, (bf16_t*)(ws + WS_WBD), scr, gw, NGW, lane);
        conv_job(0, AIN(I_WOUT), nullptr, DM, DM, DM, nullptr, (bf16_t*)(ws + WS_WOUT), scr, gw, NGW, lane);
        conv_job(0, AIN(I_WQ), nullptr, DM, 512, 512, AIN(I_CN), (bf16_t*)(ws + WS_WQ), scr, gw, NGW, lane);
        conv_job(0, AIN(I_WKV), nullptr, DM, 1024, 1024, AIN(I_MN), (bf16_t*)(ws + WS_WKV), scr, gw, NGW, lane);
        conv_job(0, AIN(I_WO), nullptr, 512, DM, DM, nullptr, (bf16_t*)(ws + WS_WO), scr, gw, NGW, lane);
        rows_to_bf16(AIN(I_X), hb, nullptr, ssqx, TOK, gw, NGW, lane);
        rows_to_bf16(AIN(I_MEM), (bf16_t*)(ws + WS_MEMB), ctl + CT_SSQM, nullptr, 1024, gw, NGW, lane);
        for (int i = bx * NTHREADS + tid; i < 4 * TOK; i += G * NTHREADS) ssqx[TOK + i] = 0ull;
        if (bx == 0 && tid < 8) ((unsigned*)ctl)[CT_CNT + tid] = 0u;
    }
    GRID_SYNC(P_PRO);
    gemm_range(a, lds, lo, hi, P_GU1, P_PROJ, G, bx, NGW, xbar);
    if (lo <= P_GDNL && P_GDNL < hi) {
        PHASE_HEAD
        GdnP GP{proj, (const bf16_t*)(ws + WS_HALO), (const float*)(ws + WS_BAF), AIN(I_CONV), AIN(I_ALOG), AIN(I_DTB), (bf16_t*)(ws + WS_WBUF), (bf16_t*)(ws + WS_ATTN), (float*)(ws + WS_CD), (float*)(ws + WS_RSTDO)};
        for (int u = bx; u < 2048; u += G) gdn_local_unit(lds, GP, u, tid, a.probe);
        float* kmean = (float*)(ws + WS_KMEAN);
        if (!(a.probe & 4)) for (int pc = gw; pc < 2048; pc += NGW) { const int part = pc & 3, it = pc >> 2, j = it & 15, bh = it >> 4, b = bh >> 3, h = bh & 7;
            const bf16_t* kp = proj + (size_t)(b * SEQ + j * 256 + part * 64) * NIN + 1024 + h * 128 + lane * 2; float s0 = 0.f, s1 = 0.f;
#pragma unroll 16
            for (int r = 0; r < 64; ++r) { const unsigned v = *(const unsigned*)(kp + (size_t)r * NIN); s0 += bflo(v); s1 += bfhi(v); }
            kmean[(size_t)pc * 128 + lane * 2] = s0 * (1.f / 256.f); kmean[(size_t)pc * 128 + lane * 2 + 1] = s1 * (1.f / 256.f); }
    }
    GRID_SYNC(P_GDNL);
    if (lo <= P_MIX && P_MIX < hi) {
        PHASE_HEAD
        GdnP GP{proj, (const bf16_t*)(ws + WS_HALO), (const float*)(ws + WS_BAF), AIN(I_CONV), AIN(I_ALOG), AIN(I_DTB), (bf16_t*)(ws + WS_WBUF), (bf16_t*)(ws + WS_ATTN), (float*)(ws + WS_CD), (float*)(ws + WS_RSTDO)};
        LAS unsigned* uslot = (LAS unsigned*)(lds + 157 * 1024);
        unsigned* cnt = (unsigned*)ctl + CT_CNT;
        if (!(a.probe & 8)) for (int c = bx; c < 32; c += G) gdn_chain(lds, GP, AIN(I_ONORM), c, tid);
        int tidA = tid; asm volatile("" : "+v"(tidA));
        const unsigned xcc = (unsigned)__builtin_amdgcn_s_getreg((3 << 11) | 20) & 7u;
        for (int qo = 0; qo < 8; ++qo) {
            const int qx = (int)((xcc + (unsigned)qo) & 7u);
            for (;;) {
                lds_barrier();
                if (tidA == 0) *uslot = atomicAdd(cnt + qx, 1u);
                lds_barrier();
                const int k = (int)*uslot;
                if (k >= 128 || (a.probe & 16)) break;
                const int qt = 31 - (k & 31), bh = qx + 8 * (k >> 5), b = bh >> 3, h = bh & 7;
                const bf16_t* base = proj + (size_t)(b * SEQ) * NIN + h * 128;
                attn_unit<true>(lds, base + (size_t)(qt * 128) * NIN, NIN, base + 1024, base + 2048, NIN, proj + (size_t)(b * SEQ + qt * 128) * NIN + h * 128, NIN, qt,
                                (const float*)(ws + WS_KMEAN) + (size_t)bh * 8192, AIN(I_RELB) + h, tidA);
            }
        }
    }
    GRID_SYNC(P_MIX);
    if (lo <= P_GFIN && P_GFIN < hi) {
        PHASE_HEAD
        const float* rstdo = (const float*)(ws + WS_RSTDO); const float* onorm = AIN(I_ONORM);
        for (int idx = bx * NTHREADS + tid; idx < TOK * 64; idx += G * NTHREADS) {
            const int token = idx >> 6, h = (idx >> 3) & 7, c16 = idx & 7;
            const bf16_t* op = proj + (size_t)token * NIN + C_GDN + 2048 + h * 128 + c16 * 16; bf16_t* zp = proj + (size_t)token * NIN + C_Z + h * 128 + c16 * 16;
            const u32x4 o0 = *(const u32x4*)op, o1 = *(const u32x4*)(op + 8), z0 = *(const u32x4*)zp, z1 = *(const u32x4*)(zp + 8);
            const float rstd = rstdo[(size_t)token * 8 + h];
#pragma unroll
            for (int hh = 0; hh < 2; ++hh) { const u32x4 ov = hh ? o1 : o0, zv = hh ? z1 : z0;
                const f32x4 g0 = *(const f32x4*)(onorm + c16 * 16 + hh * 8), g1 = *(const f32x4*)(onorm + c16 * 16 + hh * 8 + 4);
                float r[8];
#pragma unroll
                for (int e = 0; e < 4; ++e) { const float zl = bflo(zv[e]), zh = bfhi(zv[e]); const float gl = (e < 2 ? g0 : g1)[(2 * e) & 3], gh = (e < 2 ? g0 : g1)[(2 * e + 1) & 3];
                    r[2 * e] = bflo(ov[e]) * rstd * gl * zl * sigmoidf_(zl); r[2 * e + 1] = bfhi(ov[e]) * rstd * gh * zh * sigmoidf_(zh); }
                u32x4 o; o.x = pk2(r[0], r[1]); o.y = pk2(r[2], r[3]); o.z = pk2(r[4], r[5]); o.w = pk2(r[6], r[7]);
                *(u32x4*)(zp + hh * 8) = o; }
        }
    }
    GRID_SYNC(P_GFIN);
    gemm_range(a, lds, lo, hi, P_BRANCH, P_XQ, G, bx, NGW, xbar);
    if (lo <= P_XATT && P_XATT < hi) {
        PHASE_HEAD
        for (int u = bx; u < 512; u += G) { const int qt = u & 31, bh = u >> 5, b = bh >> 2, xh = bh & 3;
            const bf16_t* kv = (const bf16_t*)(ws + WS_KVX) + (size_t)(b * 256) * 1024 + xh * 128;
            attn_unit<false>(lds, (const bf16_t*)(ws + WS_QX) + (size_t)(b * SEQ + qt * 128) * 512 + xh * 128, 512, kv, kv + 512, 1024, (bf16_t*)(ws + WS_OX) + (size_t)(b * SEQ + qt * 128) * 512 + xh * 128, 512, qt, nullptr, nullptr, tid); }
    }
    GRID_SYNC(P_XATT);
    gemm_range(a, lds, lo, hi, P_XO, P_DOWN2, G, bx, NGW, xbar);
    if (lo <= P_FINAL && P_FINAL < hi) {
        PHASE_HEAD
        const u64* ssq = ssqx + 4 * TOK; const float* fn = AIN(I_FN);
        for (int row = gw; row < TOK; row += NGW) { const float rs = 1.f / sqrtf(ssq_val(ssq[row]) * (1.f / DM) + EPS);
            const u32x4* hp = (const u32x4*)(hb + (size_t)row * DM) + lane; f32x4* p = (f32x4*)(a.out + (size_t)row * DM);
            u32x4 hv[4];
#pragma unroll
            for (int j = 0; j < 4; ++j) hv[j] = hp[64 * j];
#pragma unroll
            for (int j = 0; j < 4; ++j) { const int c = (lane + 64 * j) * 8; const f32x4 g0 = *(const f32x4*)(fn + c), g1 = *(const f32x4*)(fn + c + 4); const u32x4 r = hv[j];
                p[(c >> 2)] = (f32x4){bflo(r.x), bfhi(r.x), bflo(r.y), bfhi(r.y)} * rs * g0; p[(c >> 2) + 1] = (f32x4){bflo(r.z), bfhi(r.z), bflo(r.w), bfhi(r.w)} * rs * g1; } }
    }
}

extern "C" void kernel_launch(void* const* d_in, const int* in_sizes, int n_in, void* d_out, int out_size, void* d_ws, size_t ws_size, hipStream_t stream) {
    static int grid = 0;
    if (grid == 0) {
        if (n_in != 26 || ws_size < WS_END) { fprintf(stderr, "kernel_launch: unexpected n_in %d / ws %zu\n", n_in, ws_size); grid = -1; return; }
        int dev = 0, cus = 0, per_cu = 0;
        hipGetDevice(&dev); hipDeviceGetAttribute(&cus, hipDeviceAttributeMultiprocessorCount, dev);
        hipFuncSetAttribute((const void*)mega, hipFuncAttributeMaxDynamicSharedMemorySize, LDS_BYTES);
        hipOccupancyMaxActiveBlocksPerMultiprocessor(&per_cu, (const void*)mega, NTHREADS, LDS_BYTES);
        (void)hipGetLastError();
        if (per_cu < 1) per_cu = 1;
        grid = cus;
        if (grid <= 0) grid = 256;
    }
    if (grid < 0) return;
    Args a{};
    for (int i = 0; i < 26; ++i) a.in[i] = (const float*)d_in[i];
    a.out = (float*)d_out; a.ws = (unsigned char*)d_ws;
    (void)hipMemsetAsync((char*)d_ws + WS_BAR, 0, 2 * XCD_BAR_WORDS * 4, stream);
#if MK_SINGLE
    a.ph_lo = 0; a.ph_hi = NPHASE;
    void* args[] = {&a};
    hipError_t e = hipLaunchCooperativeKernel((const void*)mega, dim3(grid), dim3(NTHREADS), args, LDS_BYTES, stream);
    if (e != hipSuccess) fprintf(stderr, "cooperative launch failed: %s (grid %d)\n", hipGetErrorString(e), grid);
    if (PROBE_PHASE >= 0) { Args b = a; b.ph_lo = PROBE_PHASE; b.ph_hi = PROBE_PHASE + 1; b.probe = 1 | (PROBE_FLAGS << 1); b.pad = 1;
        (void)hipMemsetAsync((char*)d_ws + WS_CTL + (size_t)CT_CNT * 4, 0, 32, stream);
        hipLaunchKernelGGL(mega, dim3(grid), dim3(NTHREADS), LDS_BYTES, stream, b); }
#else
    for (int ph = 0; ph < NPHASE; ++ph) { a.ph_lo = ph; a.ph_hi = ph + 1; hipLaunchKernelGGL(mega, dim3(grid), dim3(NTHREADS), LDS_BYTES, stream, a); }
#endif
}
```

```cpp
#include <hip/hip_runtime.h>
#include <hip/hip_cooperative_groups.h>
#include <cstdio>
#include <cstdint>
namespace cg = cooperative_groups;

#ifndef MK_SINGLE
#define MK_SINGLE 1
#endif
#define PROBE_PHASE -1
#define PROBE_FLAGS 0

#define LAS __attribute__((address_space(3)))
typedef unsigned short bf16_t;
typedef short bf16x8 __attribute__((ext_vector_type(8)));
typedef short s16x4 __attribute__((ext_vector_type(4)));
typedef float f32x4 __attribute__((ext_vector_type(4)));
typedef unsigned u32x4 __attribute__((ext_vector_type(4)));
typedef unsigned u32x2 __attribute__((ext_vector_type(2)));
typedef unsigned long long u64;
__device__ __forceinline__ u64 ssq_fix(float v) { return (u64)(v * 4294967296.f); }
__device__ __forceinline__ float ssq_val(u64 v) { return (float)v * (1.f / 4294967296.f); }

typedef __bf16 hbf2 __attribute__((ext_vector_type(2)));
typedef float f32x2 __attribute__((ext_vector_type(2)));
__device__ __forceinline__ unsigned pk2(float lo, float hi) { const f32x2 v = {lo, hi}; return __builtin_bit_cast(unsigned, __builtin_convertvector(v, hbf2)); }
__device__ __forceinline__ unsigned f2bf(float f) { return pk2(f, 0.f) & 0xffffu; }
__device__ __forceinline__ float bf2f(unsigned h) { return __builtin_bit_cast(float, h << 16); }
__device__ __forceinline__ float bflo(unsigned w) { return __builtin_bit_cast(float, w << 16); }
__device__ __forceinline__ float bfhi(unsigned w) { return __builtin_bit_cast(float, w & 0xffff0000u); }
__device__ __forceinline__ float sigmoidf_(float x) { return __builtin_amdgcn_rcpf(1.f + __builtin_amdgcn_exp2f(-1.4426950408889634f * x)); }
__device__ __forceinline__ float wave_sum(float v) {
#pragma unroll
    for (int o = 1; o < 64; o <<= 1) v += __shfl_xor(v, o);
    return v;
}

__device__ __forceinline__ void lds_barrier() { asm volatile("s_waitcnt lgkmcnt(0)" ::: "memory"); __builtin_amdgcn_s_barrier(); asm volatile("" ::: "memory"); }
__device__ __forceinline__ LAS unsigned char* vbase(LAS unsigned char* p) { unsigned v = (unsigned)(uintptr_t)p; asm volatile("" : "+v"(v)); return (LAS unsigned char*)(uintptr_t)v; }
constexpr int TOK = 16384, DM = 2048, FF = 5632, NGU = 11264, NIN = 11520, SEQ = 4096;
constexpr int C_GDN = 3072, C_Z = 6144, C_GA = 7168, C_GB = 9216, C_BA = 11264;
constexpr float EPS = 1e-6f;
constexpr int NTHREADS = 512, NWAVES = 8;
constexpr int LDS_BYTES = 158 * 1024;

constexpr size_t MiB = 1u << 20;
constexpr size_t WS_CTL = 0;
constexpr size_t WS_KMEAN = 1 * MiB;
constexpr size_t WS_CD = 648 * 1024;
constexpr size_t WS_BAR = 768 * 1024;
constexpr size_t WS_WBA = 2 * MiB, WS_WBD = 6 * MiB, WS_WOUT = 10 * MiB, WS_WQ = 18 * MiB, WS_WKV = 20 * MiB, WS_WO = 24 * MiB;
constexpr size_t WS_HALO = 26 * MiB;
constexpr size_t WS_BAF = 30 * MiB + 512 * 1024;
constexpr size_t WS_RSTDO = 31 * MiB + 512 * 1024;
constexpr size_t WS_MEMB = 32 * MiB, WS_KVX = 36 * MiB;
constexpr size_t WS_HB = 38 * MiB;
constexpr size_t WS_WBUF = 102 * MiB;
constexpr size_t WS_WIN = 102 * MiB;
constexpr size_t WS_ATTN = 507 * MiB;
constexpr size_t WS_PROJ = 147 * MiB;
constexpr size_t WS_HFF = 147 * MiB;
constexpr size_t WS_WGU = 323 * MiB, WS_WD = 367 * MiB;
constexpr size_t WS_QX = 389 * MiB, WS_OX = 405 * MiB;
constexpr size_t WS_END = 523 * MiB;
constexpr int CT_SSQ = 0;
constexpr int CT_SSQM = 10 * 16384;
constexpr int CT_CNT = 10 * 16384 + 1024;

namespace pg8 {
constexpr int BM = 256, BK = 64, HALF = 128, HTB = HALF * BK * 2, STAGE_BYTES = 8 * HTB, NXCD = 8, WGM = 4;
__host__ __device__ __forceinline__ int lds_byte(int r, int c) { const int st = (r >> 4) * 2 + (c >> 5), rr = r & 15, cc = c & 31, ob = rr * 64 + cc * 2; return st * 1024 + (ob ^ (((ob >> 9) & 1) << 5)); }
__host__ __device__ __forceinline__ void stage_rc(int b, int& R, int& C) { const int st = b / 1024, sb = b % 1024, swz = sb ^ (((sb >> 9) & 1) << 5); R = (st >> 1) * 16 + swz / 64; C = (st & 1) * 32 + (swz % 64) / 2; }
__host__ __device__ __forceinline__ int perm32(int rho) { const int n = rho >> 4, i = rho & 15; return 8 * (i >> 2) + 4 * n + (i & 3); }
struct Unit { int pm, pn; };
struct Gemm { const bf16_t* A; const bf16_t* Bt; int M, N, K, lda; };
struct StaticOrder {
    int nM, nN, nwg, G, c;
    __device__ void init(int M, int N, int G_, int c_) { nM = M / BM; nN = N / BM; nwg = nM * nN; G = G_; c = c_; }
    __device__ bool next(int i, Unit& u) const {
        const long L = (long)i * G + c; if (L >= nwg) return false;
        int wgid = (int)L; { const int q = nwg / NXCD, r = nwg % NXCD, xcd = wgid % NXCD, off = wgid / NXCD; wgid = (xcd < r ? xcd * (q + 1) : r * (q + 1) + (xcd - r) * q) + off; }
        const int nig = WGM * nN, gid = wgid / nig, fm = gid * WGM, gsz = (nM - fm) < WGM ? (nM - fm) : WGM;
        u.pm = fm + ((wgid % nig) % gsz); u.pn = (wgid % nig) / gsz; return true;
    }
};

enum { E_GU = 0, E_RESID = 1, E_SCALE = 2, E_BR1 = 3, E_BR2 = 4 };
struct Epi {
    int mode;
    const u64* ssq; const float* ssqf;
    bf16_t* outb; int ldo;
    const float* hin; float* hout; float alpha; u64* ssq_out; bf16_t* hb; const bf16_t* hinb;
    bf16_t* halo; float* baf;
    const bf16_t* gate;
    __device__ __forceinline__ void operator()(const f32x4 (&acc)[2][2][4][2], const Unit& u, int wr, int wc, int fr, int fq, LAS f32x4* rsc, bool reuse) const {
        const int row0 = u.pm * BM + wr * 64 + fr;
        const int cl = wc * 32 + 8 * fq;
        if (mode == E_GU || mode == E_SCALE) {
            float rs[2][4];
            if (reuse) {
                const f32x4 r0 = rsc[0], r1 = rsc[1];
#pragma unroll
                for (int m = 0; m < 4; ++m) { rs[0][m] = r0[m]; rs[1][m] = r1[m]; }
            } else {
#pragma unroll
                for (int ai = 0; ai < 2; ++ai)
#pragma unroll
                    for (int m = 0; m < 4; ++m) rs[ai][m] = ssqf ? ssqf[row0 + ai * HALF + m * 16] : ssq_val(ssq[row0 + ai * HALF + m * 16]);
#pragma unroll
                for (int ai = 0; ai < 2; ++ai)
#pragma unroll
                    for (int m = 0; m < 4; ++m) rs[ai][m] = __builtin_amdgcn_rsqf(rs[ai][m] * (1.f / DM) + EPS);
                rsc[0] = (f32x4){rs[0][0], rs[0][1], rs[0][2], rs[0][3]}; rsc[1] = (f32x4){rs[1][0], rs[1][1], rs[1][2], rs[1][3]};
            }
            if (mode == E_GU) {
#pragma unroll
                for (int ai = 0; ai < 2; ++ai)
#pragma unroll
                    for (int m = 0; m < 4; ++m) {
                        const int row = row0 + ai * HALF + m * 16; const float r = rs[ai][m];
                        float o[8];
#pragma unroll
                        for (int n = 0; n < 2; ++n)
#pragma unroll
                            for (int e = 0; e < 4; ++e) { const float g = acc[ai][0][m][n][e] * r, up = acc[ai][1][m][n][e] * r; o[n * 4 + e] = g * sigmoidf_(g) * up; }
                        u32x4 w; w.x = pk2(o[0], o[1]); w.y = pk2(o[2], o[3]); w.z = pk2(o[4], o[5]); w.w = pk2(o[6], o[7]);
                        *(u32x4*)(outb + (size_t)row * ldo + u.pn * 128 + cl) = w;
                    }
            } else {
                const bool is_ba = (baf != nullptr) && (u.pn * BM == C_BA);
                const bool is_gdn = (halo != nullptr) && (u.pn * BM >= C_GDN) && (u.pn * BM < C_Z);
#pragma unroll
                for (int ai = 0; ai < 2; ++ai)
#pragma unroll
                    for (int m = 0; m < 4; ++m) {
                        const int row = row0 + ai * HALF + m * 16; const float r = rs[ai][m];
#pragma unroll
                        for (int bj = 0; bj < 2; ++bj) {
                            const int col = u.pn * BM + bj * HALF + cl;
                            const f32x4 v0 = acc[ai][bj][m][0] * r, v1 = acc[ai][bj][m][1] * r;
                            u32x4 w; w.x = pk2(v0[0], v0[1]); w.y = pk2(v0[2], v0[3]); w.z = pk2(v1[0], v1[1]); w.w = pk2(v1[2], v1[3]);
                            if (is_ba) { if (bj == 0 && cl < 16) { *(f32x4*)(baf + (size_t)row * 16 + cl) = v0; *(f32x4*)(baf + (size_t)row * 16 + cl + 4) = v1; } }
                            else *(u32x4*)(outb + (size_t)row * ldo + col) = w;
                            if (is_gdn && m == 3 && fr >= 13) *(u32x4*)(halo + ((size_t)(row >> 6) * 3 + (fr - 13)) * 3072 + (col - C_GDN)) = w;
                        }
                    }
            }
        } else if (mode == E_RESID) {
#pragma unroll
            for (int ai = 0; ai < 2; ++ai) {
                f32x4 hv[4][2][2];
                {
                    u32x4 hr[4][2];
#pragma unroll
                    for (int m = 0; m < 4; ++m)
#pragma unroll
                        for (int bj = 0; bj < 2; ++bj) hr[m][bj] = *(const u32x4*)(hinb + (size_t)(row0 + ai * HALF + m * 16) * DM + u.pn * BM + bj * HALF + cl);
                    asm volatile("" ::: "memory");
#pragma unroll
                    for (int m = 0; m < 4; ++m)
#pragma unroll
                        for (int bj = 0; bj < 2; ++bj) { const u32x4 r = hr[m][bj]; hv[m][bj][0] = (f32x4){bflo(r.x), bfhi(r.x), bflo(r.y), bfhi(r.y)}; hv[m][bj][1] = (f32x4){bflo(r.z), bfhi(r.z), bflo(r.w), bfhi(r.w)}; }
                }
#pragma unroll
                for (int m = 0; m < 4; ++m) {
                    const int row = row0 + ai * HALF + m * 16; float ss = 0.f;
#pragma unroll
                    for (int bj = 0; bj < 2; ++bj) {
                        const size_t off = (size_t)row * DM + u.pn * BM + bj * HALF + cl;
                        const f32x4 o0 = hv[m][bj][0] + acc[ai][bj][m][0] * alpha, o1 = hv[m][bj][1] + acc[ai][bj][m][1] * alpha;
                        ss += (o0[0] * o0[0] + o0[1] * o0[1]) + (o0[2] * o0[2] + o0[3] * o0[3]) + (o1[0] * o1[0] + o1[1] * o1[1]) + (o1[2] * o1[2] + o1[3] * o1[3]);
                        if (hb) { u32x4 w; w.x = pk2(o0[0], o0[1]); w.y = pk2(o0[2], o0[3]); w.z = pk2(o1[0], o1[1]); w.w = pk2(o1[2], o1[3]); *(u32x4*)(hb + off) = w; }
                    }
                    ss += __shfl_xor(ss, 16); ss += __shfl_xor(ss, 32);
                    if (fq == 0) atomicAdd(ssq_out + row, ssq_fix(ss));
                }
            }
        } else {
#pragma unroll
            for (int ai = 0; ai < 2; ++ai) {
                u32x4 cv[4][2], gv[4][2];
#pragma unroll
                for (int m = 0; m < 4; ++m)
#pragma unroll
                    for (int bj = 0; bj < 2; ++bj) { const size_t off = (size_t)(row0 + ai * HALF + m * 16) * ldo + u.pn * BM + bj * HALF + cl;
                        cv[m][bj] = *(const u32x4*)(outb + off); gv[m][bj] = (mode == E_BR2) ? *(const u32x4*)(gate + off) : (u32x4){0u, 0u, 0u, 0u}; }
                asm volatile("" ::: "memory");
#pragma unroll
                for (int m = 0; m < 4; ++m)
#pragma unroll
                    for (int bj = 0; bj < 2; ++bj) {
                        const size_t off = (size_t)(row0 + ai * HALF + m * 16) * ldo + u.pn * BM + bj * HALF + cl;
                        const u32x4 cur = cv[m][bj], gb = gv[m][bj];
                        float o[8];
                        if (mode == E_BR1) {
#pragma unroll
                            for (int e = 0; e < 4; ++e) { o[2 * e] = sigmoidf_(bflo(cur[e])) * acc[ai][bj][m][e >> 1][(2 * e) & 3]; o[2 * e + 1] = sigmoidf_(bfhi(cur[e])) * acc[ai][bj][m][e >> 1][(2 * e + 1) & 3]; }
                        } else {
#pragma unroll
                            for (int e = 0; e < 4; ++e) { o[2 * e] = bflo(cur[e]) + sigmoidf_(bflo(gb[e])) * acc[ai][bj][m][e >> 1][(2 * e) & 3]; o[2 * e + 1] = bfhi(cur[e]) + sigmoidf_(bfhi(gb[e])) * acc[ai][bj][m][e >> 1][(2 * e + 1) & 3]; }
                        }
                        u32x4 w; w.x = pk2(o[0], o[1]); w.y = pk2(o[2], o[3]); w.z = pk2(o[4], o[5]); w.w = pk2(o[6], o[7]);
                        *(u32x4*)(outb + off) = w;
                    }
            }
        }
    }
};
__device__ __forceinline__ int rfl(int v) { return __builtin_amdgcn_readfirstlane(v); }
template <class T> __device__ __forceinline__ T* rflp(T* p) { const unsigned long long v = (unsigned long long)p; const unsigned lo = (unsigned)rfl((int)(unsigned)v), hi = (unsigned)rfl((int)(unsigned)(v >> 32)); return (T*)(((unsigned long long)hi << 32) | lo); }
__device__ __forceinline__ Epi load_epi(const LAS Epi* p) {
    Epi e; e.ssqf = rflp(p->ssqf); e.mode = rfl(p->mode);
#ifdef FORCE_MODE
    e.mode = FORCE_MODE;
#endif
 e.ssq = rflp(p->ssq); e.outb = rflp(p->outb); e.ldo = rfl(p->ldo); e.hin = rflp(p->hin); e.hout = rflp(p->hout);
    e.alpha = __builtin_bit_cast(float, rfl(__builtin_bit_cast(int, p->alpha))); e.ssq_out = rflp(p->ssq_out); e.hb = rflp(p->hb); e.halo = rflp(p->halo); e.baf = rflp(p->baf); e.gate = rflp(p->gate); e.hinb = rflp(p->hinb);
    return e;
}
__device__ __forceinline__ void gemm_phase(LAS unsigned char* lds, const Gemm g, const StaticOrder& S, const LAS Epi* Ep, const int tid) {
    const int wid = __builtin_amdgcn_readfirstlane(tid >> 6), lane = tid & 63, wr = wid >> 2, wc = wid & 3, fr = lane & 15, fq = lane >> 4;
    const int K = g.K, nt = K / BK, lda = g.lda;
    unsigned voffA[2], voffB[2];
#pragma unroll
    for (int i = 0; i < 2; ++i) { int R, C; stage_rc(tid * 16 + i * 8192, R, C); const int Rb = (R & ~31) + perm32(R & 31);
        voffA[i] = (unsigned)(R * lda + C) * 2u; voffB[i] = (unsigned)(Rb * K + C) * 2u; }
    const size_t kstep = (size_t)(BK * 2);
    const size_t hstepA = (size_t)HALF * lda * 2, hstepB = (size_t)HALF * K * 2;
    const size_t tstepA = 2 * hstepA, tstepB = 2 * hstepB;
    const unsigned ldsw = (unsigned)wid * 1024u;
    const int aoff = lds_byte(wr * 64 + fr, fq * 8), boff = lds_byte(wc * 32 + fr, fq * 8);
#define PG8_SA(b, h) (((b) * 2 + (h)) * HTB)
#define PG8_SB(b, h) ((4 + (b) * 2 + (h)) * HTB)
#define PG8_STAGE(bufoff, gbase, voff) do { _Pragma("unroll") for (int _i = 0; _i < 2; ++_i) \
        __builtin_amdgcn_global_load_lds((const unsigned*)((const char*)(gbase) + (voff)[_i]), (LAS unsigned*)(lds + (bufoff) + ldsw + _i * 8192), 16, 0, 0); } while (0)
#define PG8_LDA(dst, b, h) do { _Pragma("unroll") for (int m = 0; m < 4; ++m) _Pragma("unroll") for (int k = 0; k < 2; ++k) dst[m][k] = *(const LAS bf16x8*)(lds + PG8_SA(b, h) + aoff + m * 2048 + k * 1024); } while (0)
#define PG8_LDB(dst, b, h) do { _Pragma("unroll") for (int n = 0; n < 2; ++n) _Pragma("unroll") for (int k = 0; k < 2; ++k) dst[n][k] = *(const LAS bf16x8*)(lds + PG8_SB(b, h) + boff + n * 2048 + k * 1024); } while (0)
#define PG8_MMA(ai, bj, At, Bt) do { __builtin_amdgcn_s_setprio(1); _Pragma("unroll") for (int m = 0; m < 4; ++m) _Pragma("unroll") for (int n = 0; n < 2; ++n) _Pragma("unroll") for (int k = 0; k < 2; ++k) \
        acc[ai][bj][m][n] = __builtin_amdgcn_mfma_f32_16x16x32_bf16(Bt[n][k], At[m][k], acc[ai][bj][m][n], 0, 0, 0); __builtin_amdgcn_s_setprio(0); } while (0)
#define PG8_WAIT_V(n) asm volatile("s_waitcnt vmcnt(" #n ")" ::: "memory")
#define PG8_WAIT_L(n) asm volatile("s_waitcnt lgkmcnt(" #n ")" ::: "memory")
#define PG8_BAR __builtin_amdgcn_s_barrier()
#define PG8_SCHED __builtin_amdgcn_sched_barrier(0)
    Unit cur, nxt; int ui = 0, rs_pm = -1;
    if (!S.next(0, cur)) return;
    f32x4 acc[2][2][4][2];
#pragma unroll
    for (int a = 0; a < 2; ++a)
#pragma unroll
        for (int b = 0; b < 2; ++b)
#pragma unroll
            for (int m = 0; m < 4; ++m)
#pragma unroll
                for (int n = 0; n < 2; ++n) acc[a][b][m][n] = (f32x4){0.f, 0.f, 0.f, 0.f};
    bf16x8 At[4][2], B0[2][2], B1[2][2];
    const char* cA = (const char*)g.A + (size_t)cur.pm * tstepA; const char* cB = (const char*)g.Bt + (size_t)cur.pn * tstepB;
    PG8_STAGE(PG8_SB(0, 0), cB, voffB); PG8_STAGE(PG8_SB(0, 1), cB + hstepB, voffB); PG8_STAGE(PG8_SA(0, 0), cA, voffA); PG8_STAGE(PG8_SA(0, 1), cA + hstepA, voffA);
    if (wr == 1) PG8_BAR;
    PG8_WAIT_V(2); PG8_BAR;
    PG8_STAGE(PG8_SB(1, 0), cB + kstep, voffB); PG8_STAGE(PG8_SA(1, 0), cA + kstep, voffA); PG8_STAGE(PG8_SB(1, 1), cB + hstepB + kstep, voffB);
    PG8_WAIT_V(6); PG8_BAR;
    for (;;) {
        const bool has_next = S.next(ui + 1, nxt);
        const char* nA = has_next ? (const char*)g.A + (size_t)nxt.pm * tstepA : cA; const char* nB = has_next ? (const char*)g.Bt + (size_t)nxt.pn * tstepB : cB;
        for (int t = 0; t < nt; t += 2) {
            const bool last = (t == nt - 2);
            const char* a1 = cA + (size_t)(t + 1) * kstep;
            const char* a2 = last ? nA : cA + (size_t)(t + 2) * kstep; const char* b2 = last ? nB : cB + (size_t)(t + 2) * kstep;
            const char* a3 = a2 + kstep; const char* b3 = b2 + kstep;
            PG8_LDB(B0, 0, 0); PG8_LDB(B1, 0, 1); PG8_SCHED; PG8_LDA(At, 0, 0); PG8_STAGE(PG8_SA(1, 1), a1 + hstepA, voffA);
            PG8_WAIT_V(8); PG8_WAIT_L(0); PG8_BAR; PG8_MMA(0, 0, At, B0); PG8_MMA(0, 1, At, B1); PG8_BAR; PG8_SCHED;
            PG8_LDA(At, 0, 1); PG8_STAGE(PG8_SB(0, 0), b2, voffB); PG8_STAGE(PG8_SB(0, 1), b2 + hstepB, voffB); PG8_STAGE(PG8_SA(0, 0), a2, voffA);
            PG8_WAIT_V(8); PG8_WAIT_L(0); PG8_BAR; PG8_MMA(1, 0, At, B0); PG8_MMA(1, 1, At, B1); PG8_BAR; PG8_SCHED;
            PG8_LDB(B0, 1, 0); PG8_LDB(B1, 1, 1); PG8_SCHED; PG8_LDA(At, 1, 0); PG8_STAGE(PG8_SA(0, 1), a2 + hstepA, voffA);
            PG8_WAIT_V(8); PG8_WAIT_L(0); PG8_BAR; PG8_MMA(0, 0, At, B0); PG8_MMA(0, 1, At, B1); PG8_BAR; PG8_SCHED;
            PG8_LDA(At, 1, 1); PG8_STAGE(PG8_SB(1, 0), b3, voffB); PG8_STAGE(PG8_SB(1, 1), b3 + hstepB, voffB); PG8_STAGE(PG8_SA(1, 0), a3, voffA);
            PG8_WAIT_V(8); PG8_WAIT_L(0); PG8_BAR; PG8_MMA(1, 0, At, B0); PG8_MMA(1, 1, At, B1); PG8_BAR; PG8_SCHED;
        }
        if (wr == 0) PG8_BAR;
        { const Epi E = load_epi(Ep); E(acc, cur, wr, wc, fr, fq, (LAS f32x4*)(lds + 135168 + (wid * 64 + lane) * 32), cur.pm == rs_pm); rs_pm = cur.pm; }
        if (!has_next) break;
#pragma unroll
        for (int a = 0; a < 2; ++a)
#pragma unroll
            for (int b = 0; b < 2; ++b)
#pragma unroll
                for (int m = 0; m < 4; ++m)
#pragma unroll
                    for (int n = 0; n < 2; ++n) acc[a][b][m][n] = (f32x4){0.f, 0.f, 0.f, 0.f};
        cur = nxt; cA = nA; cB = nB; ++ui;
        if (wr == 1) PG8_BAR;
    }
    PG8_WAIT_V(0);
    PG8_BAR;
#undef PG8_SA
#undef PG8_SB
#undef PG8_STAGE
#undef PG8_LDA
#undef PG8_LDB
#undef PG8_MMA
#undef PG8_WAIT_V
#undef PG8_WAIT_L
#undef PG8_BAR
#undef PG8_SCHED
}
}

__device__ __forceinline__ void tr_item(const float* __restrict__ W, int K, int Nsrc, int col0, int nvalid, const float* __restrict__ gain, bf16_t* WT, int drow0, int k0, LAS float* scr, int lane) {
    float v[32];
#pragma unroll
    for (int i = 0; i < 32; ++i) { const int kk = 2 * i + (lane >> 5), n = lane & 31; v[i] = 0.f; if (n < nvalid) v[i] = W[(size_t)(k0 + kk) * Nsrc + col0 + n]; }
#pragma unroll
    for (int i = 0; i < 32; ++i) { const int kk = 2 * i + (lane >> 5), n = lane & 31; float x = v[i]; if (gain) x *= gain[k0 + kk]; scr[kk * 33 + n] = x; }
    const int c = lane & 7;
#pragma unroll
    for (int j = 0; j < 4; ++j) { const int n = (lane >> 3) + 8 * j; const LAS float* s = scr + (8 * c) * 33 + n;
        u32x4 o; o.x = pk2(s[0 * 33], s[1 * 33]); o.y = pk2(s[2 * 33], s[3 * 33]); o.z = pk2(s[4 * 33], s[5 * 33]); o.w = pk2(s[6 * 33], s[7 * 33]);
        *(u32x4*)(WT + (size_t)(drow0 + n) * K + k0 + 8 * c) = o; }
}
__device__ __forceinline__ void conv_job(int kind, const float* W, const float* W2, int K, int Nsrc, int Ndst, const float* gain, bf16_t* WT, LAS float* scr, int gw, int NGW, int lane) {
    const int nb = Ndst / 32, nitems = (K / 64) * nb;
    for (int it = gw; it < nitems; it += NGW) {
        const int kb = it / nb, db = it % nb, d0 = db * 32, k0 = kb * 64; const float* src = W; int col0 = d0, nvalid = 32;
        if (kind == 1) { const int t = d0 >> 8; int r = d0 & 255; if (r >= 128) { src = W2; r -= 128; } col0 = t * 128 + r; }
        else if (kind == 2) { if (d0 < 7168) col0 = d0; else if (d0 < 11264) col0 = d0 + 16; else if (d0 == 11264) { col0 = 7168; nvalid = 16; } else { col0 = 0; nvalid = 0; } }
        tr_item(src, K, Nsrc, col0, nvalid, gain, WT, d0, k0, scr, lane);
    }
}
__device__ __forceinline__ void rows_to_bf16(const float* X, bf16_t* XB, float* ssqf, u64* ssqx, int nrows, int gw, int NGW, int lane) {
    for (int row = gw; row < nrows; row += NGW) {
        const f32x4* p = (const f32x4*)(X + (size_t)row * DM) + lane; f32x4 v[8]; float ss = 0.f;
#pragma unroll
        for (int j = 0; j < 8; ++j) { v[j] = p[64 * j]; ss += (v[j].x * v[j].x + v[j].y * v[j].y) + (v[j].z * v[j].z + v[j].w * v[j].w); }
        ss = wave_sum(ss); if (lane == 0) { if (ssqf) ssqf[row] = ss; else ssqx[row] = ssq_fix(ss); }
        u32x2* o = (u32x2*)(XB + (size_t)row * DM) + lane;
#pragma unroll
        for (int j = 0; j < 8; ++j) { u32x2 w; w.x = pk2(v[j].x, v[j].y); w.y = pk2(v[j].z, v[j].w); o[64 * j] = w; }
    }
}

constexpr int AT_KS = 0, AT_VS = 34816, AT_KM = 71680, AT_SC = 79872, AT_SEL = 88064, AT_LUT = 88576, AT_PITCH = 272, AT_VP = 288;
template <bool MOBA>
__device__ __forceinline__ void attn_unit(LAS unsigned char* lds, const bf16_t* Qp, int ldq, const bf16_t* Kp, const bf16_t* Vp, int ldkv, bf16_t* Op, int ldo, int qt, const float* kmean, const float* relb, const int tid) {
    const int w = __builtin_amdgcn_readfirstlane(tid >> 6), lane = tid & 63, l15 = lane & 15, quad = lane >> 4;
    const int own = qt >> 1;
    const float L2E = 1.4426950408889634f;
    bf16x8 qf[4]; unsigned mysel = 0u, wave_mask = 0u;
    lds_barrier();
    if (MOBA) {
#pragma unroll
        for (int i = 0; i < 4; ++i) { const int id = tid + 512 * i, r = id >> 4, c = id & 15; *(LAS u32x4*)(lds + AT_KS + r * AT_PITCH + c * 16) = *(const u32x4*)(Qp + (size_t)r * ldq + c * 8); }
        for (int i = tid; i < own * 128; i += 512) { const float* kp = kmean + (size_t)(i >> 7) * 512 + (i & 127); ((LAS float*)(lds + AT_KM))[i] = (kp[0] + kp[128]) + (kp[256] + kp[384]); }
        if (tid < 128) { const int n = tid; int bk = n; if (n >= 16) { bk = 16 + (int)(logf((float)n / 16.f) / 2.0794415416798357f * 16.f); if (bk > 31) bk = 31; } ((LAS float*)(lds + AT_LUT))[tid] = relb[bk * 8] * L2E; }
        lds_barrier();
        { const int q = tid & 127, jg = tid >> 7;
          for (int j = jg; j < own; j += 4) { float d = 0.f; const LAS float* km = (const LAS float*)(lds + AT_KM) + j * 128;
#pragma unroll 4
              for (int c = 0; c < 16; ++c) { const u32x4 qv = *(const LAS u32x4*)(lds + AT_KS + q * AT_PITCH + c * 16); const f32x4 k0 = *(const LAS f32x4*)(km + c * 8), k1 = *(const LAS f32x4*)(km + c * 8 + 4);
                  d += bflo(qv.x) * k0.x + bfhi(qv.x) * k0.y + bflo(qv.y) * k0.z + bfhi(qv.y) * k0.w + bflo(qv.z) * k1.x + bfhi(qv.z) * k1.y + bflo(qv.w) * k1.z + bfhi(qv.w) * k1.w; }
              ((LAS float*)(lds + AT_SC))[q * 16 + j] = d; } }
        lds_barrier();
        if (tid < 128) { unsigned mask = 0u;
            if (own <= 3) mask = (1u << own) - 1u;
            else { const LAS float* sc = (const LAS float*)(lds + AT_SC) + tid * 16;
                for (int r = 0; r < 3; ++r) { float best = -INFINITY; int bi = 0; for (int j = 0; j < own; ++j) { const float v = sc[j]; if (!((mask >> j) & 1u) && v > best) { best = v; bi = j; } } mask |= 1u << bi; } }
            ((LAS unsigned*)(lds + AT_SEL))[tid] = mask; }
        lds_barrier();
#pragma unroll
        for (int s = 0; s < 4; ++s) qf[s] = *(const LAS bf16x8*)(lds + AT_KS + (w * 16 + l15) * AT_PITCH + (quad * 8 + 32 * s) * 2);
        mysel = ((LAS unsigned*)(lds + AT_SEL))[w * 16 + l15];
        { unsigned m = mysel; m |= __shfl_xor(m, 1); m |= __shfl_xor(m, 2); m |= __shfl_xor(m, 4); m |= __shfl_xor(m, 8); wave_mask = __builtin_amdgcn_readfirstlane(m); }
    } else {
#pragma unroll
        for (int s = 0; s < 4; ++s) qf[s] = *(const bf16x8*)(Qp + (size_t)(w * 16 + l15) * ldq + quad * 8 + 32 * s);
    }
    f32x4 oacc[8]; float mrow = -INFINITY, lrow = 0.f;
#pragma unroll
    for (int n = 0; n < 8; ++n) oacc[n] = (f32x4){0.f, 0.f, 0.f, 0.f};
    const int nhalf = MOBA ? own * 2 + (qt & 1) + 1 : 2;
    const float sc2 = 0.08838834764831845f * L2E;
    u32x4 kreg[4], vreg[4];
#pragma unroll
    for (int i = 0; i < 4; ++i) { const int id = tid + 512 * i, r = id >> 4, c = id & 15; kreg[i] = *(const u32x4*)(Kp + (size_t)r * ldkv + c * 8); vreg[i] = *(const u32x4*)(Vp + (size_t)r * ldkv + c * 8); }
#pragma unroll 1
    for (int hi = 0; hi < nhalf; ++hi) {
        const int j = hi >> 1, kr0 = hi * 128;
        lds_barrier();
#pragma unroll
        for (int i = 0; i < 4; ++i) { const int id = tid + 512 * i, r = id >> 4, c = id & 15;
            *(LAS u32x4*)(lds + AT_KS + r * AT_PITCH + c * 16) = kreg[i]; *(LAS u32x4*)(lds + AT_VS + r * AT_VP + c * 16) = vreg[i]; }
        lds_barrier();
        if (hi + 1 < nhalf) {
#pragma unroll
            for (int i = 0; i < 4; ++i) { const int id = tid + 512 * i, r = id >> 4, c = id & 15; kreg[i] = *(const u32x4*)(Kp + (size_t)(kr0 + 128 + r) * ldkv + c * 8); vreg[i] = *(const u32x4*)(Vp + (size_t)(kr0 + 128 + r) * ldkv + c * 8); }
        }
        const bool active = !MOBA || j == own || ((wave_mask >> j) & 1u);
        if (active) {
            f32x4 sacc[8];
#pragma unroll
            for (int kt = 0; kt < 8; ++kt) { sacc[kt] = (f32x4){0.f, 0.f, 0.f, 0.f};
#pragma unroll
                for (int s = 0; s < 4; ++s) { const bf16x8 kf = *(const LAS bf16x8*)(lds + AT_KS + (kt * 16 + l15) * AT_PITCH + (quad * 8 + 32 * s) * 2); sacc[kt] = __builtin_amdgcn_mfma_f32_16x16x32_bf16(kf, qf[s], sacc[kt], 0, 0, 0); }
                if (kt & 1) __builtin_amdgcn_sched_barrier(0); }
            float mx = -INFINITY; float ps = 0.f;
            bool simple = !MOBA; float cbm = 0.f;
            bool lsel = true;
            if (MOBA) {
                const bool farb = (qt * 128 + w * 16) - (kr0 + 127) >= 127;
                lsel = (j == own) || ((mysel >> j) & 1u);
                simple = farb; cbm = lsel ? ((const LAS float*)(lds + AT_LUT))[127] : -INFINITY;
            }
            if (simple) {
#pragma unroll
                for (int kt = 0; kt < 8; ++kt)
#pragma unroll
                    for (int i = 0; i < 4; ++i) mx = fmaxf(mx, sacc[kt][i]);
                mx = mx * sc2 + cbm;
            } else {
                const int qpos = qt * 128 + w * 16 + l15, kpos0 = kr0 + quad * 4;
#pragma unroll
                for (int kt = 0; kt < 8; ++kt)
#pragma unroll
                    for (int i = 0; i < 4; ++i) { const int rel = qpos - (kpos0 + kt * 16 + i);
                        const int ri = rel < 0 ? 0 : (rel > 127 ? 127 : rel); const float b = ((const LAS float*)(lds + AT_LUT))[ri];
                        const bool valid = (j == own) ? (rel >= 0) : lsel;
                        const float sv = valid ? sacc[kt][i] * sc2 + b : -INFINITY; sacc[kt][i] = sv; mx = fmaxf(mx, sv); }
            }
            mx = fmaxf(mx, __shfl_xor(mx, 16)); mx = fmaxf(mx, __shfl_xor(mx, 32));
            const float mn = fmaxf(mrow, mx), mu = (mn == -INFINITY) ? 0.f : mn, alpha = __builtin_amdgcn_exp2f(mrow - mu);
            const bool moved = mn != mrow; mrow = mn;
            if (simple) { const float off = cbm - mu;
#pragma unroll
                for (int kt = 0; kt < 8; ++kt)
#pragma unroll
                    for (int i = 0; i < 4; ++i) { const float p = __builtin_amdgcn_exp2f(sacc[kt][i] * sc2 + off); sacc[kt][i] = p; ps += p; }
            } else {
#pragma unroll
                for (int kt = 0; kt < 8; ++kt)
#pragma unroll
                    for (int i = 0; i < 4; ++i) { const float p = __builtin_amdgcn_exp2f(sacc[kt][i] - mu); sacc[kt][i] = p; ps += p; }
            }
            lrow = lrow * alpha + ps;
            if (__builtin_amdgcn_ballot_w64(moved) != 0ull) {
#pragma unroll
                for (int n = 0; n < 8; ++n) oacc[n] = oacc[n] * alpha;
            }
            const int r4 = l15 >> 2, c4 = l15 & 3;
#pragma unroll
            for (int s = 0; s < 4; ++s) {
                union { u32x4 u; bf16x8 b; } pf;
                pf.u.x = pk2(sacc[2 * s][0], sacc[2 * s][1]); pf.u.y = pk2(sacc[2 * s][2], sacc[2 * s][3]); pf.u.z = pk2(sacc[2 * s + 1][0], sacc[2 * s + 1][1]); pf.u.w = pk2(sacc[2 * s + 1][2], sacc[2 * s + 1][3]);
#pragma unroll
                for (int n = 0; n < 8; ++n) {
                    LAS unsigned char* va = lds + AT_VS + (32 * s + quad * 4 + r4) * AT_VP + (n * 16 + 4 * c4) * 2;
                    const s16x4 lo = __builtin_amdgcn_ds_read_tr16_b64_v4i16((LAS s16x4*)va);
                    const s16x4 hi4 = __builtin_amdgcn_ds_read_tr16_b64_v4i16((LAS s16x4*)(va + 16 * AT_VP));
                    const bf16x8 vf = {lo[0], lo[1], lo[2], lo[3], hi4[0], hi4[1], hi4[2], hi4[3]};
                    oacc[n] = __builtin_amdgcn_mfma_f32_16x16x32_bf16(vf, pf.b, oacc[n], 0, 0, 0);
                }
                __builtin_amdgcn_sched_barrier(0);
            }
        }
    }
    lrow += __shfl_xor(lrow, 16); lrow += __shfl_xor(lrow, 32);
    const float inv = 1.f / lrow;
#pragma unroll
    for (int n = 0; n < 8; ++n) { u32x2 o; o.x = pk2(oacc[n][0] * inv, oacc[n][1] * inv); o.y = pk2(oacc[n][2] * inv, oacc[n][3] * inv);
        *(u32x2*)(Op + (size_t)(w * 16 + l15) * ldo + n * 16 + quad * 4) = o; }
}

constexpr int GL_Q = 0, GL_K = 33792, GL_V = 67584, GL_M = 100352, GL_SM = 116736, GL_QB = 118784, GL_KB = 136192;
struct GdnP { bf16_t* proj; const bf16_t* halo; const float* baf; const float* conv; const float* a_log; const float* dt_bias; bf16_t* wbuf; bf16_t* attnb; float* cdb; float* rstdo; };
__device__ __forceinline__ void gdn_local_unit(LAS unsigned char* lds, const GdnP& P, int unit, const int tid, const int pf) {
    const int w = __builtin_amdgcn_readfirstlane(tid >> 6), lane = tid & 63, l15 = lane & 15, quad = lane >> 4;
    const int h = unit & 7, cn = unit >> 3, n = cn & 63, row0 = cn * 64;
    LAS float* Qs = (LAS float*)vbase(lds + GL_Q); LAS float* Ks = (LAS float*)vbase(lds + GL_K); LAS float* Vs = (LAS float*)vbase(lds + GL_V); LAS float* Ms = (LAS float*)vbase(lds + GL_M);
    LAS float* rq = (LAS float*)vbase(lds + GL_SM); LAS float* rk = rq + 64; LAS float* beta = rq + 128; LAS float* Gc = rq + 192; LAS float* eG = rq + 256; LAS float* gb = rq + 320;
    lds_barrier();
    if (tid < 384 && !(pf & 32)) {
        const int c8 = tid & 15, which = (tid >> 4) % 3, tseg = tid / 48, t0 = tseg * 8, col = which * 1024 + h * 128 + c8 * 8;
        float wg[4][8];
#pragma unroll
        for (int i = 0; i < 4; ++i) { const f32x4 w0 = *(const f32x4*)(P.conv + i * 3072 + col), w1 = *(const f32x4*)(P.conv + i * 3072 + col + 4);
            wg[i][0] = w0.x; wg[i][1] = w0.y; wg[i][2] = w0.z; wg[i][3] = w0.w; wg[i][4] = w1.x; wg[i][5] = w1.y; wg[i][6] = w1.z; wg[i][7] = w1.w; }
        u32x4 raw[11];
#pragma unroll
        for (int r = 0; r < 11; ++r) { const int tt = t0 - 3 + r; raw[r] = (u32x4){0u, 0u, 0u, 0u};
            if (tt >= 0) raw[r] = *(const u32x4*)(P.proj + (size_t)(row0 + tt) * NIN + C_GDN + col);
            else if (n > 0) raw[r] = *(const u32x4*)(P.halo + ((size_t)(cn - 1) * 3 + (tt + 3)) * 3072 + col); }
#pragma unroll
        for (int r = 0; r < 8; ++r) { float a[8] = {0.f, 0.f, 0.f, 0.f, 0.f, 0.f, 0.f, 0.f};
#pragma unroll
            for (int i = 0; i < 4; ++i) { const u32x4 rv = raw[r + i];
                a[0] += wg[i][0] * bflo(rv.x); a[1] += wg[i][1] * bfhi(rv.x); a[2] += wg[i][2] * bflo(rv.y); a[3] += wg[i][3] * bfhi(rv.y);
                a[4] += wg[i][4] * bflo(rv.z); a[5] += wg[i][5] * bfhi(rv.z); a[6] += wg[i][6] * bflo(rv.w); a[7] += wg[i][7] * bfhi(rv.w); }
#pragma unroll
            for (int e = 0; e < 8; ++e) a[e] = a[e] * sigmoidf_(a[e]);
            const int t = t0 + r;
            LAS float* dst = (which == 0 ? Qs + t * 132 : (which == 1 ? Ks + t * 132 : Vs + t * 128)) + c8 * 8;
            *(LAS f32x4*)dst = (f32x4){a[0], a[1], a[2], a[3]}; *(LAS f32x4*)(dst + 4) = (f32x4){a[4], a[5], a[6], a[7]}; }
    }
    lds_barrier();
    if (tid < 128) { const int r = tid & 63; const LAS float* arr = (tid < 64 ? Qs : Ks) + r * 132; float ss = 0.f;
#pragma unroll 8
        for (int c = 0; c < 32; ++c) { const f32x4 v = *(const LAS f32x4*)(arr + 4 * c); ss += (v.x * v.x + v.y * v.y) + (v.z * v.z + v.w * v.w); }
        const float rn = 1.f / sqrtf(ss + EPS); if (tid < 64) rq[r] = rn * 0.08838834764831845f; else rk[r] = rn; }
    else if (tid < 192) { const int t = tid - 128; const float bl = P.baf[(size_t)(row0 + t) * 16 + h], al = P.baf[(size_t)(row0 + t) * 16 + 8 + h];
        beta[t] = 1.f / (1.f + expf(-bl)); const float x = al + P.dt_bias[h]; const float sp = x > 20.f ? x : log1pf(expf(x)); gb[t] = -expf(P.a_log[h]) * sp; }
    lds_barrier();
    if (tid < 64) { float v = gb[tid];
#pragma unroll
        for (int o = 1; o < 64; o <<= 1) { const float y = __shfl_up(v, o); if (lane >= o) v += y; }
        Gc[tid] = v; eG[tid] = expf(v); }
    for (int it = tid; it < 2048; it += 512) { const int which = it >> 10, rem = it & 1023, t = rem >> 4, c8 = rem & 15; const LAS float* src = (which ? Ks : Qs) + t * 132 + c8 * 8; const float r = which ? rk[t] : rq[t];
        const f32x4 v0 = *(const LAS f32x4*)src, v1 = *(const LAS f32x4*)(src + 4); u32x4 o; o.x = pk2(v0.x * r, v0.y * r); o.y = pk2(v0.z * r, v0.w * r); o.z = pk2(v1.x * r, v1.y * r); o.w = pk2(v1.z * r, v1.w * r);
        *(LAS u32x4*)(lds + (which ? GL_KB : GL_QB) + t * 272 + c8 * 16) = o; }
    lds_barrier();
    { const int mt = w & 3; const bool isq = w >= 4; const int abase = isq ? GL_QB : GL_KB;
      bf16x8 af[4];
#pragma unroll
      for (int s = 0; s < 4; ++s) af[s] = *(const LAS bf16x8*)(lds + abase + (mt * 16 + l15) * 272 + (quad * 8 + 32 * s) * 2);
      for (int nt = 0; nt < 4; ++nt) {
          f32x4 acc = (f32x4){0.f, 0.f, 0.f, 0.f};
          if (nt <= mt) {
#pragma unroll
              for (int s = 0; s < 4; ++s) { const bf16x8 bfr = *(const LAS bf16x8*)(lds + GL_KB + (nt * 16 + l15) * 272 + (quad * 8 + 32 * s) * 2); acc = __builtin_amdgcn_mfma_f32_16x16x32_bf16(af[s], bfr, acc, 0, 0, 0); }
          }
          const int j = nt * 16 + l15;
#pragma unroll
          for (int i = 0; i < 4; ++i) { const int c = mt * 16 + quad * 4 + i; const float dec = __expf(Gc[c] - Gc[j]);
              if (!isq) Ms[c * 64 + j] = (c > j) ? acc[i] * beta[c] * dec : 0.f;
              else P.attnb[(size_t)unit * 4096 + c * 64 + j] = (bf16_t)f2bf((c >= j) ? acc[i] * dec : 0.f); }
      } }
    lds_barrier();
    if (tid < 256 && !(pf & 2)) {
        const int col = tid; f32x2 sol2[32];
        if (col < 128) {
#pragma unroll
            for (int t = 0; t < 64; ++t) sol2[t >> 1][t & 1] = Vs[t * 128 + col] * beta[t];
        } else {
#pragma unroll
            for (int t = 0; t < 64; ++t) sol2[t >> 1][t & 1] = Ks[t * 132 + col - 128] * rk[t] * beta[t] * eG[t];
        }
#pragma unroll
        for (int c = 1; c < 64; ++c) { f32x2 sp = (f32x2){sol2[c >> 1][c & 1], 0.f};
#pragma unroll
            for (int jb = 0; jb <= (c - 1) / 4; ++jb) { const f32x4 m4 = *(const LAS f32x4*)(Ms + c * 64 + 4 * jb);
                sp -= (f32x2){m4.x, m4.y} * sol2[2 * jb]; sp -= (f32x2){m4.z, m4.w} * sol2[2 * jb + 1]; }
            sol2[c >> 1][c & 1] = sp.x + sp.y; }
        if (col < 128) {
#pragma unroll
            for (int t = 0; t < 64; ++t) Vs[t * 128 + col] = sol2[t >> 1][t & 1];
        } else {
#pragma unroll
            for (int t = 0; t < 64; ++t) *(LAS bf16_t*)(lds + GL_QB + t * 272 + (col - 128) * 2) = (bf16_t)f2bf(sol2[t >> 1][t & 1]);
        }
    } else if (tid >= 256) {
        const int t2 = tid - 256; const float GL = Gc[63];
        for (int it = t2; it < 1024; it += 256) { const int t = it >> 4, c8 = it & 15; const float r = rq[t] * eG[t]; const LAS float* src = Qs + t * 132 + c8 * 8;
            const f32x4 v0 = *(const LAS f32x4*)src, v1 = *(const LAS f32x4*)(src + 4); u32x4 o; o.x = pk2(v0.x * r, v0.y * r); o.y = pk2(v0.z * r, v0.w * r); o.z = pk2(v1.x * r, v1.y * r); o.w = pk2(v1.z * r, v1.w * r);
            *(u32x4*)(P.proj + (size_t)(row0 + t) * NIN + C_GDN + h * 128 + c8 * 8) = o; }
        for (int it = t2; it < 1024; it += 256) { const int kidx = it & 127, t8 = it >> 7; float v[8];
#pragma unroll
            for (int e = 0; e < 8; ++e) { const int t = t8 * 8 + e; v[e] = Ks[t * 132 + kidx] * rk[t] * __expf(GL - Gc[t]); }
            u32x4 o; o.x = pk2(v[0], v[1]); o.y = pk2(v[2], v[3]); o.z = pk2(v[4], v[5]); o.w = pk2(v[6], v[7]);
            *(u32x4*)(P.proj + (size_t)(row0 + (kidx >> 1)) * NIN + C_GDN + 1024 + h * 128 + (kidx & 1) * 64 + t8 * 8) = o; }
        if (t2 == 0) P.cdb[unit] = expf(GL);
    }
    lds_barrier();
    for (int it = tid; it < 1024; it += 512) { const int t = it >> 4, c8 = it & 15;
        const int half = it & 1, ln = (it >> 1) & 63, nh2 = (it >> 7) & 1, mt2 = it >> 8, ql = ln >> 4, ll = ln & 15; float uvv[8];
#pragma unroll
        for (int e = 0; e < 8; ++e) uvv[e] = Vs[(mt2 * 16 + ql * 4 + (e & 3)) * 128 + (4 * nh2 + 2 * half + (e >> 2)) * 16 + ll];
        u32x4 o; o.x = pk2(uvv[0], uvv[1]); o.y = pk2(uvv[2], uvv[3]); o.z = pk2(uvv[4], uvv[5]); o.w = pk2(uvv[6], uvv[7]);
        *(u32x4*)(P.proj + (size_t)(row0 + t) * NIN + C_GDN + 2048 + h * 128 + c8 * 8) = o;
        *(u32x4*)(P.wbuf + (size_t)unit * 8192 + t * 128 + c8 * 8) = *(const LAS u32x4*)(lds + GL_QB + t * 272 + c8 * 16); }
}

constexpr int GC_ST = 0, GC_VT = 34816, GC_RED = 53248, GC_ON = 53760, GC_OB = 54272;
struct ChainOps { bf16x8 wf[4], qf[4], af[2], kf[2]; u32x4 uf[2]; float cd; };
__device__ __forceinline__ void chain_load(ChainOps& o, const GdnP& P, int b, int h, int n, int w, int mt, int nh, int lane, int tid) {
    const int l15 = lane & 15, quad = lane >> 4;
    const int cn = b * 64 + n, unit = cn * 8 + h, row0 = cn * 64;
    const bf16_t* wrow = P.wbuf + (size_t)unit * 8192 + (mt * 16 + l15) * 128 + quad * 8;
    const bf16_t* qrow = P.proj + (size_t)(row0 + mt * 16 + l15) * NIN + C_GDN + h * 128 + quad * 8;
#pragma unroll
    for (int s = 0; s < 4; ++s) { o.wf[s] = *(const bf16x8*)(wrow + 32 * s); o.qf[s] = *(const bf16x8*)(qrow + 32 * s); }
    const bf16_t* arow = P.attnb + (size_t)unit * 4096 + (mt * 16 + l15) * 64 + quad * 8;
    const int kidx = w * 16 + l15;
    const bf16_t* krow = P.proj + (size_t)(row0 + (kidx >> 1)) * NIN + C_GDN + 1024 + h * 128 + (kidx & 1) * 64 + quad * 8;
#pragma unroll
    for (int s = 0; s < 2; ++s) { o.af[s] = *(const bf16x8*)(arow + 32 * s); o.kf[s] = *(const bf16x8*)(krow + 32 * s); }
    o.cd = P.cdb[unit];
    const int cb = ((mt * 2 + nh) * 64 + lane) * 2;
    const bf16_t* up = P.proj + (size_t)(row0 + (cb >> 4)) * NIN + C_GDN + 2048 + h * 128 + (cb & 15) * 8;
    o.uf[0] = *(const u32x4*)up; o.uf[1] = *(const u32x4*)(up + 8);
}
__device__ __forceinline__ void gdn_chain(LAS unsigned char* lds, const GdnP& P, const float* out_norm, int bh, const int tid) {
    const int w = __builtin_amdgcn_readfirstlane(tid >> 6), lane = tid & 63, l15 = lane & 15, quad = lane >> 4;
    const int b = bh >> 3, h = bh & 7, mt = w & 3, nh = w >> 2;
    f32x4 sacc[8];
#pragma unroll
    for (int n = 0; n < 8; ++n) sacc[n] = (f32x4){0.f, 0.f, 0.f, 0.f};
    lds_barrier();
    for (int i = tid; i < 34816 / 16; i += 512) *(LAS u32x4*)(lds + GC_ST + i * 16) = (u32x4){0u, 0u, 0u, 0u};
    ChainOps cur, nxt;
    chain_load(cur, P, b, h, 0, w, mt, nh, lane, tid);
    lds_barrier();
    for (int n = 0; n < 64; ++n) {
        const int row0 = (b * 64 + n) * 64;
        chain_load(nxt, P, b, h, n < 63 ? n + 1 : n, w, mt, nh, lane, tid);
        f32x4 oacc[4];
#pragma unroll
        for (int q = 0; q < 4; ++q) { const int nt = 4 * nh + q; f32x4 a1 = (f32x4){0.f, 0.f, 0.f, 0.f}; oacc[q] = (f32x4){0.f, 0.f, 0.f, 0.f};
#pragma unroll
            for (int s = 0; s < 4; ++s) { const bf16x8 sf = *(const LAS bf16x8*)(lds + GC_ST + (nt * 16 + l15) * 272 + (quad * 8 + 32 * s) * 2);
                a1 = __builtin_amdgcn_mfma_f32_16x16x32_bf16(cur.wf[s], sf, a1, 0, 0, 0); oacc[q] = __builtin_amdgcn_mfma_f32_16x16x32_bf16(cur.qf[s], sf, oacc[q], 0, 0, 0); }
            const unsigned u01 = cur.uf[q >> 1][(q & 1) * 2], u23 = cur.uf[q >> 1][(q & 1) * 2 + 1];
            u32x2 pv; pv.x = pk2(bflo(u01) - a1[0], bfhi(u01) - a1[1]); pv.y = pk2(bflo(u23) - a1[2], bfhi(u23) - a1[3]);
            *(LAS u32x2*)(lds + GC_VT + (nt * 16 + l15) * 144 + (mt * 16 + quad * 4) * 2) = pv; }
        lds_barrier();
        float ss[4] = {0.f, 0.f, 0.f, 0.f};
#pragma unroll
        for (int q = 0; q < 4; ++q) { const int nt = 4 * nh + q;
#pragma unroll
            for (int s = 0; s < 2; ++s) { const bf16x8 vf = *(const LAS bf16x8*)(lds + GC_VT + (nt * 16 + l15) * 144 + (quad * 8 + 32 * s) * 2); oacc[q] = __builtin_amdgcn_mfma_f32_16x16x32_bf16(cur.af[s], vf, oacc[q], 0, 0, 0); }
#pragma unroll
            for (int i = 0; i < 4; ++i) { ss[i] += oacc[q][i] * oacc[q][i]; *(LAS bf16_t*)(lds + GC_OB + (mt * 16 + quad * 4 + i) * 272 + (nt * 16 + l15) * 2) = (bf16_t)f2bf(oacc[q][i]); } }
#pragma unroll
        for (int nt = 0; nt < 8; ++nt) { sacc[nt] = sacc[nt] * cur.cd;
#pragma unroll
            for (int s = 0; s < 2; ++s) { const bf16x8 vf = *(const LAS bf16x8*)(lds + GC_VT + (nt * 16 + l15) * 144 + (quad * 8 + 32 * s) * 2); sacc[nt] = __builtin_amdgcn_mfma_f32_16x16x32_bf16(cur.kf[s], vf, sacc[nt], 0, 0, 0); }
            u32x2 pv; pv.x = pk2(sacc[nt][0], sacc[nt][1]); pv.y = pk2(sacc[nt][2], sacc[nt][3]);
            *(LAS u32x2*)(lds + GC_ST + (nt * 16 + l15) * 272 + (w * 16 + quad * 4) * 2) = pv; }
#pragma unroll
        for (int i = 0; i < 4; ++i) { float s = ss[i]; s += __shfl_xor(s, 1); s += __shfl_xor(s, 2); s += __shfl_xor(s, 4); s += __shfl_xor(s, 8); if (l15 == 0) ((LAS float*)(lds + GC_RED))[(mt * 16 + quad * 4 + i) * 2 + nh] = s; }
        lds_barrier();
        { const int t = tid >> 3, c16 = tid & 7;
          bf16_t* op = P.proj + (size_t)(row0 + t) * NIN + C_GDN + 2048 + h * 128 + c16 * 16;
          *(u32x4*)op = *(const LAS u32x4*)(lds + GC_OB + t * 272 + c16 * 32); *(u32x4*)(op + 8) = *(const LAS u32x4*)(lds + GC_OB + t * 272 + c16 * 32 + 16);
          if (c16 == 0) { const float tot = ((LAS float*)(lds + GC_RED))[t * 2] + ((LAS float*)(lds + GC_RED))[t * 2 + 1]; P.rstdo[(size_t)(row0 + t) * 8 + h] = __builtin_amdgcn_rsqf(tot * (1.f / 128.f) + EPS); } }
        cur = nxt;
    }
}

#define XB_TMO      128
#define XB_XCNT(j)  (256  + 64 * (j))
#define XB_XSUB(j)  (1280 + 64 * (j))
#define XB_XGEN(j)  (2304 + 64 * (j))
#define XB_TOP      3328
#define XB_TOPGEN   3392
#define XCD_BAR_WORDS 3456
#define XB_SPIN_CAP (1u << 18)

__device__ __forceinline__ unsigned xb_ld(unsigned* p)              { return __hip_atomic_load(p, __ATOMIC_RELAXED, __HIP_MEMORY_SCOPE_AGENT); }
__device__ __forceinline__ unsigned xb_add(unsigned* p, unsigned v) { return __hip_atomic_fetch_add(p, v, __ATOMIC_RELAXED, __HIP_MEMORY_SCOPE_AGENT); }
__device__ __forceinline__ unsigned xb_xcc_id() { return (unsigned)__builtin_amdgcn_s_getreg((3 << 11) | 20) & 0xFu; }
#define XB_SPIN(cond, bar) do { unsigned _sp = 0; while (cond) { __builtin_amdgcn_s_sleep(1); \
    if ((++_sp & 255u) == 0u) { if (xb_ld(&(bar)[XB_TMO])) break; if (_sp > XB_SPIN_CAP) { atomicAdd(&(bar)[XB_TMO], 1u); break; } } } } while (0)

struct XcdBarrier {
    unsigned* bar; unsigned x;
    volatile LAS unsigned* st;
};

__device__ __forceinline__ XcdBarrier xcd_barrier_post(unsigned* bar, volatile LAS unsigned* st) {
    XcdBarrier b; b.bar = bar; b.x = xb_xcc_id(); b.st = st;
    if (threadIdx.x == 0) (void)xb_add(&bar[XB_XCNT(b.x)], 1u);
    return b;
}
__device__ __forceinline__ void xcd_barrier_complete(unsigned* bar, unsigned x, unsigned& nloc, unsigned& nx) {
    const unsigned G = gridDim.x * gridDim.y * gridDim.z;
    unsigned sum, cnt, mine, sp = 0u;
    for (;;) {
        sum = 0u; cnt = 0u; mine = 0u;
#pragma unroll
        for (unsigned j = 0; j < 16; ++j) { const unsigned c = xb_ld(&bar[XB_XCNT(j)]); sum += c; cnt += (c > 0u) ? 1u : 0u; mine = (j == x) ? c : mine; }
        if (sum == G) break;
        __builtin_amdgcn_s_sleep(1);
        if ((++sp & 255u) == 0u) { if (xb_ld(&bar[XB_TMO])) break; if (sp > XB_SPIN_CAP) { atomicAdd(&bar[XB_TMO], 1u); break; } }
    }
    nloc = mine > 0u ? mine : 1u; nx = cnt > 0u ? cnt : 1u;
}

__device__ __forceinline__ void xcd_barrier(const XcdBarrier& b) {
    asm volatile("s_waitcnt vmcnt(0)" ::: "memory");
    __syncthreads();
    if (threadIdx.x == 0) {
        unsigned* bar = b.bar;
        __builtin_amdgcn_s_waitcnt(0);
        unsigned nloc = b.st[0], nx = b.st[1];
        if (nloc == 0u) { xcd_barrier_complete(bar, b.x, nloc, nx); b.st[0] = nloc; b.st[1] = nx; }
        const unsigned old = xb_add(&bar[XB_XSUB(b.x)], 1u);
        const unsigned gen = old / nloc;
        if (old + 1u == (gen + 1u) * nloc) {
            __builtin_amdgcn_fence(__ATOMIC_RELEASE, "agent");
            asm volatile("s_waitcnt vmcnt(0)" ::: "memory");
            const unsigned og = xb_add(&bar[XB_TOP], 1u);
            const unsigned tg = og / nx;
            if (og + 1u == (tg + 1u) * nx) xb_add(&bar[XB_TOPGEN], 1u);
            else XB_SPIN(xb_ld(&bar[XB_TOPGEN]) == tg, bar);
            __builtin_amdgcn_fence(__ATOMIC_ACQUIRE, "agent");
            xb_add(&bar[XB_XGEN(b.x)], 1u);
            asm volatile("s_waitcnt vmcnt(0)" ::: "memory");
        } else {
            XB_SPIN(xb_ld(&bar[XB_XGEN(b.x)]) == gen, bar);
            __builtin_amdgcn_fence(__ATOMIC_ACQUIRE, "agent");
            asm volatile("s_waitcnt vmcnt(0)" ::: "memory");
        }
    }
    __syncthreads();
}


enum { P_PRO = 0, P_GU1, P_DOWN1, P_PROJ, P_GDNL, P_MIX, P_GFIN, P_BRANCH, P_WOUT, P_XQ, P_XATT, P_XO, P_GU2, P_DOWN2, P_FINAL, NPHASE };
struct Args { const float* in[26]; float* out; unsigned char* ws; int ph_lo, ph_hi, probe, pad; };
enum { I_X = 0, I_MEM, I_F1N, I_F1G, I_F1U, I_F1D, I_MIXN, I_WIN, I_CONV, I_ALOG, I_DTB, I_ONORM, I_RELB, I_WBA, I_WBD, I_WOUT, I_CN, I_MN, I_WQ, I_WKV, I_WO, I_F2N, I_F2G, I_F2U, I_F2D, I_FN };

#define AIN(k) (a.in[(k) + zs])
#define PHASE_HEAD \
    int zs = 0; asm volatile("" : "+s"(zs)); \
    unsigned char* ws = a.ws + zs; float* ctl = (float*)(ws + WS_CTL); u64* ssqx = (u64*)(ws + WS_CTL); (void)ssqx; \
    bf16_t* proj = (bf16_t*)(ws + WS_PROJ); bf16_t* hb = (bf16_t*)(ws + WS_HB); bf16_t* hff = (bf16_t*)(ws + WS_HFF); \
    int tidL = threadIdx.x; asm volatile("" : "+v"(tidL)); \
    const int tid = tidL, lane = tid & 63, wave = __builtin_amdgcn_readfirstlane(tid >> 6), gw = bx * NWAVES + wave; \
    (void)ctl; (void)proj; (void)hb; (void)hff; (void)lane; (void)gw;
#define GRID_SYNC(k) do { if (lo <= (k) && (k) + 1 < hi) { if (hi > 1000) cg::this_grid().sync(); else xcd_barrier(xbar); } } while (0)

__device__ __forceinline__ void gemm_range(const Args& a, LAS unsigned char* lds, int lo, int hi, int first, int last, int G, int bx, int NGW, const XcdBarrier& xbar) {
    for (int ph = (lo > first ? lo : first); ph <= last && ph < hi; ++ph) {
        PHASE_HEAD
        const int ng = (ph == P_BRANCH || ph == P_XQ) ? 2 : 1;
        for (int gi = 0; gi < ng; ++gi) {
            pg8::Gemm g{}; pg8::Epi E{}; int rot = 0;
            switch (ph) {
            case P_GU1: g = {hb, (const bf16_t*)(ws + WS_WGU), TOK, NGU, DM, DM}; E.mode = pg8::E_GU; E.ssq = ssqx; E.outb = hff; E.ldo = FF; break;
            case P_DOWN1: g = {hff, (const bf16_t*)(ws + WS_WD), TOK, DM, FF, FF}; E.mode = pg8::E_RESID; E.hinb = hb; E.hout = nullptr; E.alpha = 0.5f; E.ssq_out = ssqx + TOK; E.hb = hb; break;
            case P_PROJ: g = {hb, (const bf16_t*)(ws + WS_WIN), TOK, NIN, DM, DM}; E.mode = pg8::E_SCALE; E.ssq = ssqx + TOK; E.outb = proj; E.ldo = NIN; E.halo = (bf16_t*)(ws + WS_HALO); E.baf = (float*)(ws + WS_BAF); break;
            case P_BRANCH:
                if (gi == 0) { g = {proj, (const bf16_t*)(ws + WS_WBA), TOK, DM, 1024, NIN}; E.mode = pg8::E_BR1; }
                else { g = {proj + C_Z, (const bf16_t*)(ws + WS_WBD), TOK, DM, 1024, NIN}; E.mode = pg8::E_BR2; E.gate = proj + C_GB; }
                E.outb = proj + C_GA; E.ldo = NIN; break;
            case P_WOUT: g = {proj + C_GA, (const bf16_t*)(ws + WS_WOUT), TOK, DM, DM, NIN}; E.mode = pg8::E_RESID; E.hinb = hb; E.hout = nullptr; E.alpha = 1.f; E.ssq_out = ssqx + 2 * TOK; E.hb = hb; break;
            case P_XQ:
                if (gi == 0) { g = {hb, (const bf16_t*)(ws + WS_WQ), TOK, 512, DM, DM}; E.ssq = ssqx + 2 * TOK; E.outb = (bf16_t*)(ws + WS_QX); E.ldo = 512; }
                else { g = {(const bf16_t*)(ws + WS_MEMB), (const bf16_t*)(ws + WS_WKV), 1024, 1024, DM, DM}; E.ssqf = ctl + CT_SSQM; E.outb = (bf16_t*)(ws + WS_KVX); E.ldo = 1024; rot = 128; }
                E.mode = pg8::E_SCALE; break;
            case P_XO: g = {(const bf16_t*)(ws + WS_OX), (const bf16_t*)(ws + WS_WO), TOK, DM, 512, 512}; E.mode = pg8::E_RESID; E.hinb = hb; E.hout = nullptr; E.alpha = 1.f; E.ssq_out = ssqx + 3 * TOK; E.hb = hb; break;
            case P_GU2: g = {hb, (const bf16_t*)(ws + WS_WGU), TOK, NGU, DM, DM}; E.mode = pg8::E_GU; E.ssq = ssqx + 3 * TOK; E.outb = hff; E.ldo = FF; break;
            default: g = {hff, (const bf16_t*)(ws + WS_WD), TOK, DM, FF, FF}; E.mode = pg8::E_RESID; E.hinb = hb; E.hout = nullptr; E.alpha = 0.5f; E.ssq_out = ssqx + 4 * TOK; E.hb = hb; break;
            }
            if (a.probe && E.mode == pg8::E_RESID) { if (E.hout) E.hout = (float*)(ws + 389 * MiB); E.ssq_out = (u64*)(ws + 524 * MiB); if (E.hb) E.hb = (bf16_t*)(ws + 38 * MiB); }
            pg8::StaticOrder S; S.init(g.M, g.N, G, (bx + rot) % G);
            __syncthreads();
            if (tid == 0) { LAS pg8::Epi* d = (LAS pg8::Epi*)(lds + 157 * 1024 + 64); d->ssqf = E.ssqf; d->mode = E.mode; d->ssq = E.ssq; d->outb = E.outb; d->ldo = E.ldo; d->hin = E.hin; d->hout = E.hout; d->alpha = E.alpha; d->ssq_out = E.ssq_out; d->hb = E.hb; d->halo = E.halo; d->baf = E.baf; d->gate = E.gate; d->hinb = E.hinb; }
            __syncthreads();
            pg8::gemm_phase(lds, g, S, (const LAS pg8::Epi*)(lds + 157 * 1024 + 64), tid);
            __syncthreads();
        }
        if (ph == P_XQ) {
            LAS float* scr = (LAS float*)(lds + wave * 8704);
            conv_job(1, AIN(I_F2G), AIN(I_F2U), DM, FF, NGU, AIN(I_F2N), (bf16_t*)(ws + WS_WGU), scr, gw, NGW, lane);
            conv_job(0, AIN(I_F2D), nullptr, FF, DM, DM, nullptr, (bf16_t*)(ws + WS_WD), scr, gw, NGW, lane);
        }
        GRID_SYNC(ph);
    }
}

__global__ void __launch_bounds__(NTHREADS, 2) mega(Args a) {
    extern __shared__ __attribute__((aligned(16))) unsigned char lds_raw[];
    LAS unsigned char* lds = (LAS unsigned char*)lds_raw;
    const int G = gridDim.x, bx = blockIdx.x, NGW = G * NWAVES;
    const int lo = a.ph_lo, hi = a.ph_hi;
    if (threadIdx.x < 4) ((LAS unsigned*)(lds + 157 * 1024 + 256))[threadIdx.x] = 0u;
    __syncthreads();
    const XcdBarrier xbar = xcd_barrier_post((unsigned*)(a.ws + WS_BAR) + a.pad * XCD_BAR_WORDS, (volatile LAS unsigned*)(lds + 157 * 1024 + 256));
    if (lo <= P_PRO && P_PRO < hi) {
        PHASE_HEAD
        LAS float* scr = (LAS float*)(lds + wave * 8704);
        conv_job(1, AIN(I_F1G), AIN(I_F1U), DM, FF, NGU, AIN(I_F1N), (bf16_t*)(ws + WS_WGU), scr, gw, NGW, lane);
        conv_job(0, AIN(I_F1D), nullptr, FF, DM, DM, nullptr, (bf16_t*)(ws + WS_WD), scr, gw, NGW, lane);
        conv_job(2, AIN(I_WIN), nullptr, DM, 11280, NIN, AIN(I_MIXN), (bf16_t*)(ws + WS_WIN), scr, gw, NGW, lane);
        conv_job(0, AIN(I_WBA), nullptr, 1024, DM, DM, nullptr, (bf16_t*)(ws + WS_WBA), scr, gw, NGW, lane);
        conv_job(0, AIN(I_WBD), nullptr, 1024, DM, DM, nullptr, (bf16_t*)(ws + WS_WBD), scr, gw, NGW, lane);
        conv_job(0, AIN(I_WOUT), nullptr, DM, DM, DM, nullptr, (bf16_t*)(ws + WS_WOUT), scr, gw, NGW, lane);
        conv_job(0, AIN(I_WQ), nullptr, DM, 512, 512, AIN(I_CN), (bf16_t*)(ws + WS_WQ), scr, gw, NGW, lane);
        conv_job(0, AIN(I_WKV), nullptr, DM, 1024, 1024, AIN(I_MN), (bf16_t*)(ws + WS_WKV), scr, gw, NGW, lane);
        conv_job(0, AIN(I_WO), nullptr, 512, DM, DM, nullptr, (bf16_t*)(ws + WS_WO), scr, gw, NGW, lane);
        rows_to_bf16(AIN(I_X), hb, nullptr, ssqx, TOK, gw, NGW, lane);
        rows_to_bf16(AIN(I_MEM), (bf16_t*)(ws + WS_MEMB), ctl + CT_SSQM, nullptr, 1024, gw, NGW, lane);
        for (int i = bx * NTHREADS + tid; i < 4 * TOK; i += G * NTHREADS) ssqx[TOK + i] = 0ull;
        if (bx == 0 && tid < 8) ((unsigned*)ctl)[CT_CNT + tid] = 0u;
    }
    GRID_SYNC(P_PRO);
    gemm_range(a, lds, lo, hi, P_GU1, P_PROJ, G, bx, NGW, xbar);
    if (lo <= P_GDNL && P_GDNL < hi) {
        PHASE_HEAD
        GdnP GP{proj, (const bf16_t*)(ws + WS_HALO), (const float*)(ws + WS_BAF), AIN(I_CONV), AIN(I_ALOG), AIN(I_DTB), (bf16_t*)(ws + WS_WBUF), (bf16_t*)(ws + WS_ATTN), (float*)(ws + WS_CD), (float*)(ws + WS_RSTDO)};
        for (int u = bx; u < 2048; u += G) gdn_local_unit(lds, GP, u, tid, a.probe);
        float* kmean = (float*)(ws + WS_KMEAN);
        if (!(a.probe & 4)) for (int pc = gw; pc < 2048; pc += NGW) { const int part = pc & 3, it = pc >> 2, j = it & 15, bh = it >> 4, b = bh >> 3, h = bh & 7;
            const bf16_t* kp = proj + (size_t)(b * SEQ + j * 256 + part * 64) * NIN + 1024 + h * 128 + lane * 2; float s0 = 0.f, s1 = 0.f;
#pragma unroll 16
            for (int r = 0; r < 64; ++r) { const unsigned v = *(const unsigned*)(kp + (size_t)r * NIN); s0 += bflo(v); s1 += bfhi(v); }
            kmean[(size_t)pc * 128 + lane * 2] = s0 * (1.f / 256.f); kmean[(size_t)pc * 128 + lane * 2 + 1] = s1 * (1.f / 256.f); }
    }
    GRID_SYNC(P_GDNL);
    if (lo <= P_MIX && P_MIX < hi) {
        PHASE_HEAD
        GdnP GP{proj, (const bf16_t*)(ws + WS_HALO), (const float*)(ws + WS_BAF), AIN(I_CONV), AIN(I_ALOG), AIN(I_DTB), (bf16_t*)(ws + WS_WBUF), (bf16_t*)(ws + WS_ATTN), (float*)(ws + WS_CD), (float*)(ws + WS_RSTDO)};
        LAS unsigned* uslot = (LAS unsigned*)(lds + 157 * 1024);
        unsigned* cnt = (unsigned*)ctl + CT_CNT;
        if (!(a.probe & 8)) for (int c = bx; c < 32; c += G) gdn_chain(lds, GP, AIN(I_ONORM), c, tid);
        int tidA = tid; asm volatile("" : "+v"(tidA));
        const unsigned xcc = (unsigned)__builtin_amdgcn_s_getreg((3 << 11) | 20) & 7u;
        for (int qo = 0; qo < 8; ++qo) {
            const int qx = (int)((xcc + (unsigned)qo) & 7u);
            for (;;) {
                lds_barrier();
                if (tidA == 0) *uslot = atomicAdd(cnt + qx, 1u);
                lds_barrier();
                const int k = (int)*uslot;
                if (k >= 128 || (a.probe & 16)) break;
                const int qt = 31 - (k & 31), bh = qx + 8 * (k >> 5), b = bh >> 3, h = bh & 7;
                const bf16_t* base = proj + (size_t)(b * SEQ) * NIN + h * 128;
                attn_unit<true>(lds, base + (size_t)(qt * 128) * NIN, NIN, base + 1024, base + 2048, NIN, proj + (size_t)(b * SEQ + qt * 128) * NIN + h * 128, NIN, qt,
                                (const float*)(ws + WS_KMEAN) + (size_t)bh * 8192, AIN(I_RELB) + h, tidA);
            }
        }
    }
    GRID_SYNC(P_MIX);
    if (lo <= P_GFIN && P_GFIN < hi) {
        PHASE_HEAD
        const float* rstdo = (const float*)(ws + WS_RSTDO); const float* onorm = AIN(I_ONORM);
        for (int idx = bx * NTHREADS + tid; idx < TOK * 64; idx += G * NTHREADS) {
            const int token = idx >> 6, h = (idx >> 3) & 7, c16 = idx & 7;
            const bf16_t* op = proj + (size_t)token * NIN + C_GDN + 2048 + h * 128 + c16 * 16; bf16_t* zp = proj + (size_t)token * NIN + C_Z + h * 128 + c16 * 16;
            const u32x4 o0 = *(const u32x4*)op, o1 = *(const u32x4*)(op + 8), z0 = *(const u32x4*)zp, z1 = *(const u32x4*)(zp + 8);
            const float rstd = rstdo[(size_t)token * 8 + h];
#pragma unroll
            for (int hh = 0; hh < 2; ++hh) { const u32x4 ov = hh ? o1 : o0, zv = hh ? z1 : z0;
                const f32x4 g0 = *(const f32x4*)(onorm + c16 * 16 + hh * 8), g1 = *(const f32x4*)(onorm + c16 * 16 + hh * 8 + 4);
                float r[8];
#pragma unroll
                for (int e = 0; e < 4; ++e) { const float zl = bflo(zv[e]), zh = bfhi(zv[e]); const float gl = (e < 2 ? g0 : g1)[(2 * e) & 3], gh = (e < 2 ? g0 : g1)[(2 * e + 1) & 3];
                    r[2 * e] = bflo(ov[e]) * rstd * gl * zl * sigmoidf_(zl); r[2 * e + 1] = bfhi(ov[e]) * rstd * gh * zh * sigmoidf_(zh); }
                u32x4 o; o.x = pk2(r[0], r[1]); o.y = pk2(r[2], r[3]); o.z = pk2(r[4], r[5]); o.w = pk2(r[6], r[7]);
                *(u32x4*)(zp + hh * 8) = o; }
        }
    }
    GRID_SYNC(P_GFIN);
    gemm_range(a, lds, lo, hi, P_BRANCH, P_XQ, G, bx, NGW, xbar);
    if (lo <= P_XATT && P_XATT < hi) {
        PHASE_HEAD
        for (int u = bx; u < 512; u += G) { const int qt = u & 31, bh = u >> 5, b = bh >> 2, xh = bh & 3;
            const bf16_t* kv = (const bf16_t*)(ws + WS_KVX) + (size_t)(b * 256) * 1024 + xh * 128;
            attn_unit<false>(lds, (const bf16_t*)(ws + WS_QX) + (size_t)(b * SEQ + qt * 128) * 512 + xh * 128, 512, kv, kv + 512, 1024, (bf16_t*)(ws + WS_OX) + (size_t)(b * SEQ + qt * 128) * 512 + xh * 128, 512, qt, nullptr, nullptr, tid); }
    }
    GRID_SYNC(P_XATT);
    gemm_range(a, lds, lo, hi, P_XO, P_DOWN2, G, bx, NGW, xbar);
    if (lo <= P_FINAL && P_FINAL < hi) {
        PHASE_HEAD
        const u64* ssq = ssqx + 4 * TOK; const float* fn = AIN(I_FN);
        for (int row = gw; row < TOK; row += NGW) { const float rs = 1.f / sqrtf(ssq_val(ssq[row]) * (1.f / DM) + EPS);
            const u32x4* hp = (const u32x4*)(hb + (size_t)row * DM) + lane; f32x4* p = (f32x4*)(a.out + (size_t)row * DM);
            u32x4 hv[4];
#pragma unroll
            for (int j = 0; j < 4; ++j) hv[j] = hp[64 * j];
#pragma unroll
            for (int j = 0; j < 4; ++j) { const int c = (lane + 64 * j) * 8; const f32x4 g0 = *(const f32x4*)(fn + c), g1 = *(const f32x4*)(fn + c + 4); const u32x4 r = hv[j];
                p[(c >> 2)] = (f32x4){bflo(r.x), bfhi(r.x), bflo(r.y), bfhi(r.y)} * rs * g0; p[(c >> 2) + 1] = (f32x4){bflo(r.z), bfhi(r.z), bflo(r.w), bfhi(r.w)} * rs * g1; } }
    }
}

extern "C" void kernel_launch(void* const* d_in, const int* in_sizes, int n_in, void* d_out, int out_size, void* d_ws, size_t ws_size, hipStream_t stream) {
    static int grid = 0;
    if (grid == 0) {
        if (n_in != 26 || ws_size < WS_END) { fprintf(stderr, "kernel_launch: unexpected n_in %d / ws %zu\n", n_in, ws_size); grid = -1; return; }
        int dev = 0, cus = 0, per_cu = 0;
        hipGetDevice(&dev); hipDeviceGetAttribute(&cus, hipDeviceAttributeMultiprocessorCount, dev);
        hipFuncSetAttribute((const void*)mega, hipFuncAttributeMaxDynamicSharedMemorySize, LDS_BYTES);
        hipOccupancyMaxActiveBlocksPerMultiprocessor(&per_cu, (const void*)mega, NTHREADS, LDS_BYTES);
        (void)hipGetLastError();
        if (per_cu < 1) per_cu = 1;
        grid = cus;
        if (grid <= 0) grid = 256;
    }
    if (grid < 0) return;
    Args a{};
    for (int i = 0; i < 26; ++i) a.in[i] = (const float*)d_in[i];
    a.out = (float*)d_out; a.ws = (unsigned char*)d_ws;
    (void)hipMemsetAsync((char*)d_ws + WS_BAR, 0, 2 * XCD_BAR_WORDS * 4, stream);
#if MK_SINGLE
    a.ph_lo = 0; a.ph_hi = NPHASE;
    void* args[] = {&a};
    hipError_t e = hipLaunchCooperativeKernel((const void*)mega, dim3(grid), dim3(NTHREADS), args, LDS_BYTES, stream);
    if (e != hipSuccess) fprintf(stderr, "cooperative launch failed: %s (grid %d)\n", hipGetErrorString(e), grid);
    if (PROBE_PHASE >= 0) { Args b = a; b.ph_lo = PROBE_PHASE; b.ph_hi = PROBE_PHASE + 1; b.probe = 1 | (PROBE_FLAGS << 1); b.pad = 1;
        (void)hipMemsetAsync((char*)d_ws + WS_CTL + (size_t)CT_CNT * 4, 0, 32, stream);
        hipLaunchKernelGGL(mega, dim3(grid), dim3(NTHREADS), LDS_BYTES, stream, b); }
#else
    for (int ph = 0; ph < NPHASE; ++ph) { a.ph_lo = ph; a.ph_hi = ph + 1; hipLaunchKernelGGL(mega, dim3(grid), dim3(NTHREADS), LDS_BYTES, stream, a); }
#endif
}
```
